# Optimizing an MI355X kernel written in HIP

```python
import jax
import jax.numpy as jnp
from jax import lax

D_MODEL = 1024
BATCH = 4
SEQ = 4096
DEPTH = 1

GRID_W = 64
CTX_LEN = 256
CHUNK = 128
GMLP_HEADS = 4
GMLP_W = D_MODEL // 2
GMLP_DH = GMLP_W // GMLP_HEADS
MLSTM_HEADS = 4
MLSTM_W = D_MODEL // 2
MLSTM_DH = MLSTM_W // MLSTM_HEADS
D_MIX = GMLP_W + MLSTM_W
CONV_W = 3
N_EXPERTS = 16
EC_FACTOR = 2
D_EXPERT = 2 * D_MODEL
EPS = 1e-6

U_COL = 0
VG_COL = GMLP_W
Q_COL = 2 * GMLP_W
O_COL = Q_COL + MLSTM_W
K_COL = O_COL + MLSTM_W
PROJ_W = K_COL + 2 * MLSTM_W + 4 * MLSTM_HEADS

kernel_name = 'hybrid_gmlp_mlstm_expert_choice_dit_block'


def rms_norm(x, g):
    xf = x.astype(jnp.float32)
    y = xf * lax.rsqrt(jnp.mean(xf * xf, axis=-1, keepdims=True) + EPS)
    return (y * g).astype(x.dtype)


def layer_norm_plain(x):
    xf = x.astype(jnp.float32)
    mu = jnp.mean(xf, axis=-1, keepdims=True)
    var = jnp.mean(jnp.square(xf - mu), axis=-1, keepdims=True)
    return ((xf - mu) * lax.rsqrt(var + EPS)).astype(x.dtype)


def adaln(cond, w, b, n):
    m = jax.nn.silu(cond) @ w[:, :n * D_MODEL] + b[:n * D_MODEL]
    return jnp.split(m, n, axis=-1)


def centred_dwconv(x, w):
    k = w.shape[0]
    pad = k // 2
    n = x.shape[1]
    xp = jnp.pad(x, ((0, 0), (pad, pad), (0, 0)))
    return sum(xp[:, j:j + n] * w[j] for j in range(k))


def to_heads(a, n_heads):
    b, n, w = a.shape
    return a.reshape(b, n, n_heads, w // n_heads).transpose(0, 2, 1, 3)


def gmlp_mix(u_pre, v_pre, ws, bs, n_chunks):
    b, n, _ = u_pre.shape
    u = jax.nn.gelu(u_pre)
    v = layer_norm_plain(jax.nn.gelu(v_pre))
    v = v.reshape(b, n_chunks, CHUNK, GMLP_HEADS, GMLP_DH)
    s = jnp.einsum('hpq,bnqhd->bnphd', ws, v) + bs.T[None, None, :, :, None]
    return u * s.reshape(b, n, GMLP_W)


def zero_state(b):
    return (jnp.zeros((b, MLSTM_HEADS, MLSTM_DH, MLSTM_DH), jnp.float32),
            jnp.zeros((b, MLSTM_HEADS, MLSTM_DH), jnp.float32),
            jnp.zeros((b, MLSTM_HEADS), jnp.float32))


def mlstm_kv_gates(p_kv, conv_k, b_i, b_f):
    b, n, _ = p_kv.shape
    k = jax.nn.silu(centred_dwconv(p_kv[..., :MLSTM_W], conv_k)) * (MLSTM_DH ** -0.5)
    v = p_kv[..., MLSTM_W:2 * MLSTM_W]
    g0 = 2 * MLSTM_W
    i_pre = p_kv[..., g0:g0 + 2 * MLSTM_HEADS].astype(jnp.float32).reshape(b, n, 2, MLSTM_HEADS) + b_i
    f_pre = p_kv[..., g0 + 2 * MLSTM_HEADS:].astype(jnp.float32).reshape(b, n, 2, MLSTM_HEADS) + b_f
    log_i = jnp.transpose(i_pre, (2, 0, 3, 1))
    log_f = jax.nn.log_sigmoid(jnp.transpose(f_pre, (2, 0, 3, 1)))
    return to_heads(k, MLSTM_HEADS), to_heads(v, MLSTM_HEADS), log_i, log_f


def mlstm_scan(q, k, v, log_i, log_f, state):
    b, h, n, dh = q.shape
    nc = n // CHUNK

    def to_chunks(a):
        a = a.astype(jnp.float32)
        return jnp.moveaxis(a.reshape((b, h, nc, CHUNK) + a.shape[3:]), 2, 0)

    xs = tuple(to_chunks(a) for a in (q, k, v, log_i, log_f))
    causal = jnp.tril(jnp.ones((CHUNK, CHUNK), dtype=bool))

    def step(carry, inp):
        c_prev, n_prev, m_prev = carry
        qc, kc, vc, li, lf = inp
        bcum = jnp.cumsum(lf, axis=-1)
        g = bcum + m_prev[..., None]
        dmat = jnp.where(causal, bcum[..., :, None] - bcum[..., None, :] + li[..., None, :], -jnp.inf)
        m_t = jnp.maximum(g, jnp.max(dmat, axis=-1))
        inter = jnp.exp(g - m_t)
        s = jnp.einsum('bhtd,bhsd->bhts', qc, kc) * jnp.exp(dmat - m_t[..., None])
        num = inter[..., None] * jnp.einsum('bhvd,bhtd->bhtv', c_prev, qc) + jnp.einsum('bhts,bhsv->bhtv', s, vc)
        den = inter * jnp.einsum('bhd,bhtd->bht', n_prev, qc) + jnp.sum(s, axis=-1)
        h_out = num / jnp.maximum(jnp.abs(den), jnp.exp(-m_t))[..., None]
        b_last = bcum[..., -1]
        a = b_last[..., None] - bcum + li
        m_new = jnp.maximum(b_last + m_prev, jnp.max(a, axis=-1))
        decay = jnp.exp(b_last + m_prev - m_new)
        wk = jnp.exp(a - m_new[..., None])[..., None] * kc
        c_new = decay[..., None, None] * c_prev + jnp.einsum('bhsv,bhsd->bhvd', vc, wk)
        n_new = decay[..., None] * n_prev + jnp.sum(wk, axis=2)
        return (c_new, n_new, m_new), h_out

    state, hs = lax.scan(step, state, xs)
    return jnp.moveaxis(hs, 0, 2).reshape(b, h, n, dh), state


def mlstm_state_from_zero(k, v, log_i, log_f):
    k = k.astype(jnp.float32)
    v = v.astype(jnp.float32)
    bcum = jnp.cumsum(log_f, axis=-1)
    b_last = bcum[..., -1]
    a = b_last[..., None] - bcum + log_i
    m = jnp.maximum(b_last, jnp.max(a, axis=-1))
    wk = jnp.exp(a - m[..., None])[..., None] * k
    return (jnp.einsum('bhsv,bhsd->bhvd', v, wk), jnp.sum(wk, axis=2), m)


def head_norm(h, g):
    mu = jnp.mean(h, axis=-1, keepdims=True)
    var = jnp.mean(jnp.square(h - mu), axis=-1, keepdims=True)
    hn = (h - mu) * lax.rsqrt(var + EPS)
    b, nh, n, dh = h.shape
    return hn.transpose(0, 2, 1, 3).reshape(b, n, nh * dh) * g


def hybrid_mixer(p, n_chunks, conv_q, conv_k, b_i, b_f, ws, bs, norm_g, w_out, st_f, st_b):
    y_g = gmlp_mix(p[..., U_COL:U_COL + GMLP_W], p[..., VG_COL:VG_COL + GMLP_W], ws, bs, n_chunks)
    q = to_heads(jax.nn.silu(centred_dwconv(p[..., Q_COL:Q_COL + MLSTM_W], conv_q)), MLSTM_HEADS)
    o = jax.nn.sigmoid(p[..., O_COL:O_COL + MLSTM_W])
    k, v, log_i, log_f = mlstm_kv_gates(p[..., K_COL:], conv_k, b_i, b_f)
    h_f, st_f = mlstm_scan(q, k, v, log_i[0], log_f[0], st_f)
    h_b, st_b = mlstm_scan(jnp.flip(q, 2), jnp.flip(k, 2), jnp.flip(v, 2),
                           jnp.flip(log_i[1], 2), jnp.flip(log_f[1], 2), st_b)
    h = head_norm(h_f + jnp.flip(h_b, 2), norm_g).astype(p.dtype)
    y_m = o * h
    y = jnp.concatenate([y_g, y_m], axis=-1) @ w_out
    return y, st_f, st_b


def expert_choice_ffn(h, w_router, w_gate, w_up, w_down, capacity):
    n_tok, d = h.shape[1], h.shape[2]
    aff = jax.nn.softmax(jnp.einsum('bnd,de->bne', h, w_router).astype(jnp.float32), axis=-1)
    gate, idx = lax.top_k(jnp.swapaxes(aff, 1, 2), capacity)
    xe = jax.vmap(lambda hb, ib: hb[ib])(h, idx)
    a = jnp.einsum('becd,edf->becf', xe, w_gate)
    u = jnp.einsum('becd,edf->becf', xe, w_up)
    ye = jnp.einsum('becf,efd->becd', jax.nn.silu(a) * u, w_down) * gate[..., None].astype(h.dtype)
    scatter = lambda ib, yb: jnp.zeros((n_tok, d), yb.dtype).at[ib.reshape(-1)].add(yb.reshape(-1, d))
    return jax.vmap(scatter)(idx, ye)


def setup_inputs(seed: int = 0) -> dict:
    key = jax.random.key(seed)
    ks = jax.random.split(key, 22)
    nrm = lambda k, shape, s: jax.random.normal(k, shape, jnp.float32) * s
    f_bias = jnp.linspace(3.0, 6.0, MLSTM_HEADS, dtype=jnp.float32)
    return {
        'x': nrm(ks[0], (BATCH, SEQ, D_MODEL), 1.0),
        'c': nrm(ks[1], (BATCH, D_MODEL), 1.0),
        'ctx': nrm(ks[2], (BATCH, CTX_LEN, D_MODEL), 1.0),
        'c_ctx': nrm(ks[3], (D_MODEL,), 1.0),
        'w_mod': nrm(ks[4], (DEPTH, D_MODEL, 6 * D_MODEL), 0.5 * D_MODEL ** -0.5),
        'b_mod': nrm(ks[5], (DEPTH, 6 * D_MODEL), 0.02),
        'norm_mix_g': 1.0 + nrm(ks[6], (DEPTH, D_MODEL), 0.02),
        'w_in': nrm(ks[7], (DEPTH, D_MODEL, PROJ_W), D_MODEL ** -0.5),
        'conv_q': nrm(ks[8], (DEPTH, CONV_W, MLSTM_W), CONV_W ** -0.5),
        'conv_k': nrm(ks[9], (DEPTH, CONV_W, MLSTM_W), CONV_W ** -0.5),
        'b_igate': nrm(ks[10], (DEPTH, 2, MLSTM_HEADS), 0.1),
        'b_fgate': f_bias + nrm(ks[11], (DEPTH, 2, MLSTM_HEADS), 0.1),
        'gmlp_ws': nrm(ks[12], (DEPTH, GMLP_HEADS, CHUNK, CHUNK), CHUNK ** -0.5),
        'gmlp_bs': 1.0 + nrm(ks[13], (DEPTH, GMLP_HEADS, CHUNK), 0.02),
        'mlstm_norm_g': 1.0 + nrm(ks[14], (DEPTH, MLSTM_W), 0.02),
        'w_out': nrm(ks[15], (DEPTH, D_MIX, D_MODEL), D_MIX ** -0.5),
        'norm_ffn_g': 1.0 + nrm(ks[16], (DEPTH, D_MODEL), 0.02),
        'w_router': nrm(ks[17], (DEPTH, D_MODEL, N_EXPERTS), D_MODEL ** -0.5),
        'w_gate_e': nrm(ks[18], (DEPTH, N_EXPERTS, D_MODEL, D_EXPERT), D_MODEL ** -0.5),
        'w_up_e': nrm(ks[19], (DEPTH, N_EXPERTS, D_MODEL, D_EXPERT), D_MODEL ** -0.5),
        'w_down_e': nrm(ks[20], (DEPTH, N_EXPERTS, D_EXPERT, D_MODEL), D_EXPERT ** -0.5),
        'final_g': 1.0 + nrm(ks[21], (D_MODEL,), 0.02),
    }


def reference(x, c, ctx, c_ctx, w_mod, b_mod, norm_mix_g, w_in, conv_q, conv_k, b_igate, b_fgate,
              gmlp_ws, gmlp_bs, mlstm_norm_g, w_out, norm_ffn_g, w_router, w_gate_e, w_up_e,
              w_down_e, final_g):
    rows = x.shape[1] // GRID_W
    n_lat = rows * GRID_W
    lat_chunks = n_lat // CHUNK
    cap_lat = EC_FACTOR * n_lat // N_EXPERTS
    cap_ctx = EC_FACTOR * ctx.shape[1] // N_EXPERTS
    for l in range(DEPTH):
        h_c = rms_norm(ctx, norm_mix_g[l])
        if l == DEPTH - 1:
            sh_c, sc_c = adaln(c_ctx, w_mod[l], b_mod[l], 2)
            p_c = (h_c * (1.0 + sc_c) + sh_c) @ w_in[l][:, K_COL:]
            k_c, v_c, li_c, lf_c = mlstm_kv_gates(p_c, conv_k[l], b_igate[l], b_fgate[l])
            st_f = mlstm_state_from_zero(k_c, v_c, li_c[0], lf_c[0])
            st_b = mlstm_state_from_zero(jnp.flip(k_c, 2), jnp.flip(v_c, 2),
                                         jnp.flip(li_c[1], 2), jnp.flip(lf_c[1], 2))
        else:
            sh_c, sc_c, g_c, sh2_c, sc2_c, g2_c = adaln(c_ctx, w_mod[l], b_mod[l], 6)
            zero = zero_state(ctx.shape[0])
            y_c, st_f, st_b = hybrid_mixer((h_c * (1.0 + sc_c) + sh_c) @ w_in[l], ctx.shape[1] // CHUNK,
                                           conv_q[l], conv_k[l], b_igate[l], b_fgate[l], gmlp_ws[l],
                                           gmlp_bs[l], mlstm_norm_g[l], w_out[l], zero, zero)
            ctx = ctx + g_c * y_c
            h2_c = rms_norm(ctx, norm_ffn_g[l]) * (1.0 + sc2_c) + sh2_c
            ctx = ctx + g2_c * expert_choice_ffn(h2_c, w_router[l], w_gate_e[l], w_up_e[l], w_down_e[l], cap_ctx)
        sh, sc, g, sh2, sc2, g2 = (m[:, None, :] for m in adaln(c, w_mod[l], b_mod[l], 6))
        h = rms_norm(x, norm_mix_g[l]) * (1.0 + sc) + sh
        y, _, _ = hybrid_mixer(h @ w_in[l], lat_chunks, conv_q[l], conv_k[l], b_igate[l], b_fgate[l],
                               gmlp_ws[l], gmlp_bs[l], mlstm_norm_g[l], w_out[l], st_f, st_b)
        x = x + g * y
        h2 = rms_norm(x, norm_ffn_g[l]) * (1.0 + sc2) + sh2
        x = x + g2 * expert_choice_ffn(h2, w_router[l], w_gate_e[l], w_up_e[l], w_down_e[l], cap_lat)
    return rms_norm(x, final_g)
```

```cpp
#include <hip/hip_runtime.h>
#include <cstdio>
#include <cstdint>

#ifndef MK_N_LAUNCHES
#define MK_N_LAUNCHES 1
#endif
#ifndef NAIVE_GEMM
#define NAIVE_GEMM 0
#endif
#ifndef NAIVE_MM
#define NAIVE_MM 0
#endif

#define LAS __attribute__((address_space(3)))
#define GAS __attribute__((address_space(1)))
typedef unsigned short bf16;
typedef float f32x2 __attribute__((ext_vector_type(2)));
typedef float f32x4 __attribute__((ext_vector_type(4)));
typedef float f32x16 __attribute__((ext_vector_type(16)));
typedef short bf16x8 __attribute__((ext_vector_type(8)));
typedef short s16x4 __attribute__((ext_vector_type(4)));
typedef unsigned u32x2 __attribute__((ext_vector_type(2)));
typedef unsigned u32x4 __attribute__((ext_vector_type(4)));
typedef LAS unsigned char* ldsp;
typedef const LAS unsigned char* ldscp;

constexpr int D = 1024, NB = 4, SEQ = 4096, CTXL = 256, NLAT = NB * SEQ, NCTX = NB * CTXL, NROWS = NLAT + NCTX;
constexpr int PROJ_W = 3088, PW = 3072, NH = 4, DH = 128, CH = 128, NCHUNK = SEQ / CH, NE = 16, CAP = 512, DE = 2048;
constexpr int NSCAN = NB * NH * 2, NSTEP = NCHUNK + 2;
constexpr float EPS = 1e-6f;
constexpr int NPH = 12;

constexpr size_t MiB = 1u << 20;
constexpr size_t WS_CTL = 0, CTL_BYTES = 64 * 1024;
constexpr size_t WS_MOD = 1 * MiB;
constexpr size_t WS_GATES = 2 * MiB;
constexpr size_t WS_AFFT = 4 * MiB;
constexpr size_t WS_SLOT = 5 * MiB;
constexpr size_t WS_GATEV = 6 * MiB;
constexpr size_t WS_SC = 7 * MiB;
constexpr size_t WS_MST = WS_SC + 64 * 1024, WS_NST = WS_SC + 128 * 1024;
constexpr size_t WS_WINT = 8 * MiB;
constexpr size_t WS_WOUTT = 14 * MiB;
constexpr size_t WS_WSB = 16 * MiB;
constexpr size_t WS_DN = 17 * MiB;
constexpr size_t WS_WE1 = 32 * MiB;
constexpr size_t WS_WE2 = 160 * MiB;
constexpr size_t WS_H = 224 * MiB;
constexpr size_t WS_P = 258 * MiB;
constexpr size_t WS_PCTX = 354 * MiB;
constexpr size_t WS_DC = 356 * MiB;
constexpr size_t WS_CST = 426 * MiB;
constexpr size_t WS_YMIX = 460 * MiB;
constexpr size_t WS_XE = 256 * MiB;
constexpr size_t WS_HID = 320 * MiB;
constexpr size_t WS_YE = 448 * MiB;
constexpr size_t WS_END = 512 * MiB;

constexpr int RING_BYTES = 131072, TAB_OFF = 131072, TAB_BYTES = 12288, MISC_OFF = TAB_OFF + TAB_BYTES, LDS_BYTES = 147456;
constexpr int TILE_BYTES = 32768;

__device__ __forceinline__ unsigned f2bf(float f) { unsigned u = __builtin_bit_cast(unsigned, f); return (u + 0x7fffu + ((u >> 16) & 1u)) >> 16; }
__device__ __forceinline__ unsigned pk2(float lo, float hi) { return f2bf(lo) | (f2bf(hi) << 16); }
__device__ __forceinline__ float bf2f(unsigned b) { return __builtin_bit_cast(float, b << 16); }
__device__ __forceinline__ float bflo(unsigned w) { return __builtin_bit_cast(float, w << 16); }
__device__ __forceinline__ float bfhi(unsigned w) { return __builtin_bit_cast(float, w & 0xffff0000u); }
__device__ __forceinline__ float silu_f(float x) { return x / (1.f + __expf(-x)); }
__device__ __forceinline__ float sigmoid_f(float x) { return 1.f / (1.f + __expf(-x)); }
__device__ __forceinline__ float gelu_f(float x) { const float t = 1.5957691216f * (x + 0.044715f * x * x * x); return x / (1.f + __expf(-t)); }
__device__ __forceinline__ float logsig_f(float x) { return fminf(x, 0.f) - log1pf(__expf(-fabsf(x))); }
__device__ __forceinline__ float wave_sum(float v) {
#pragma unroll
    for (int o = 1; o < 64; o <<= 1) v += __shfl_xor(v, o);
    return v;
}
#define LDS_WAIT() asm volatile("s_waitcnt lgkmcnt(0)" ::: "memory")
#define VM_WAIT() asm volatile("s_waitcnt vmcnt(0)" ::: "memory")

#define XB_TMO      128
#define XB_XCNT(j)  (256  + 64 * (j))
#define XB_XSUB(j)  (1280 + 64 * (j))
#define XB_XGEN(j)  (2304 + 64 * (j))
#define XB_TOP      3328
#define XB_TOPGEN   3392
#define XCD_BAR_WORDS 3456
#define XB_SPIN_CAP (1u << 22)
__device__ __forceinline__ unsigned xb_ld(unsigned* p)              { return __hip_atomic_load(p, __ATOMIC_RELAXED, __HIP_MEMORY_SCOPE_AGENT); }
__device__ __forceinline__ unsigned xb_add(unsigned* p, unsigned v) { return __hip_atomic_fetch_add(p, v, __ATOMIC_RELAXED, __HIP_MEMORY_SCOPE_AGENT); }
__device__ __forceinline__ unsigned xb_xcc_id() { return (unsigned)__builtin_amdgcn_s_getreg((3 << 11) | 20) & 0xFu; }
#define XB_SPIN(cond, bar) do { unsigned _sp = 0; while (cond) { __builtin_amdgcn_s_sleep(1); \
    if ((++_sp & 255u) == 0u) { if (xb_ld(&(bar)[XB_TMO])) break; if (_sp > XB_SPIN_CAP) { atomicAdd(&(bar)[XB_TMO], 1u); break; } } } } while (0)
struct XcdBarrier { unsigned* bar; unsigned x; volatile LAS unsigned* st; };
__device__ __forceinline__ XcdBarrier xcd_barrier_post(unsigned* bar, volatile LAS unsigned* st) {
    XcdBarrier b; b.bar = bar; b.x = xb_xcc_id(); b.st = st;
    if (threadIdx.x == 0) (void)xb_add(&bar[XB_XCNT(b.x)], 1u);
    return b;
}
__device__ __forceinline__ void xcd_barrier_complete(unsigned* bar, unsigned x, unsigned& nloc, unsigned& nx) {
    const unsigned G = gridDim.x * gridDim.y * gridDim.z;
    unsigned sum, cnt, mine, sp = 0u;
    for (;;) {
        sum = 0u; cnt = 0u; mine = 0u;
#pragma unroll
        for (unsigned j = 0; j < 16; ++j) { const unsigned c = xb_ld(&bar[XB_XCNT(j)]); sum += c; cnt += (c > 0u) ? 1u : 0u; mine = (j == x) ? c : mine; }
        if (sum == G) break;
        __builtin_amdgcn_s_sleep(1);
        if ((++sp & 255u) == 0u) { if (xb_ld(&bar[XB_TMO])) break; if (sp > XB_SPIN_CAP) { atomicAdd(&bar[XB_TMO], 1u); break; } }
    }
    nloc = mine > 0u ? mine : 1u; nx = cnt > 0u ? cnt : 1u;
}
__device__ __forceinline__ void xcd_barrier(const XcdBarrier& b) {
    asm volatile("s_waitcnt vmcnt(0)" ::: "memory");
    __syncthreads();
    if (threadIdx.x == 0) {
        unsigned* bar = b.bar;
        __builtin_amdgcn_s_waitcnt(0);
        unsigned nloc = b.st[0], nx = b.st[1];
        if (nloc == 0u) { xcd_barrier_complete(bar, b.x, nloc, nx); b.st[0] = nloc; b.st[1] = nx; }
        const unsigned old = xb_add(&bar[XB_XSUB(b.x)], 1u);
        const unsigned gen = old / nloc;
        if (old + 1u == (gen + 1u) * nloc) {
            __builtin_amdgcn_fence(__ATOMIC_RELEASE, "agent");
            asm volatile("s_waitcnt vmcnt(0)" ::: "memory");
            const unsigned og = xb_add(&bar[XB_TOP], 1u);
            const unsigned tg = og / nx;
            if (og + 1u == (tg + 1u) * nx) xb_add(&bar[XB_TOPGEN], 1u);
            else XB_SPIN(xb_ld(&bar[XB_TOPGEN]) == tg, bar);
            __builtin_amdgcn_fence(__ATOMIC_ACQUIRE, "agent");
            xb_add(&bar[XB_XGEN(b.x)], 1u);
            asm volatile("s_waitcnt vmcnt(0)" ::: "memory");
        } else {
            XB_SPIN(xb_ld(&bar[XB_XGEN(b.x)]) == gen, bar);
            __builtin_amdgcn_fence(__ATOMIC_ACQUIRE, "agent");
            asm volatile("s_waitcnt vmcnt(0)" ::: "memory");
        }
    }
    __syncthreads();
}

struct Params { const float* in[22]; float* out; unsigned char* ws; int ph_lo, ph_hi; };
enum { I_X = 0, I_C, I_CTX, I_CCTX, I_WMOD, I_BMOD, I_GMIX, I_WIN, I_CONVQ, I_CONVK, I_BI, I_BF, I_GWS, I_GBS, I_MNG, I_WOUT, I_GFFN, I_WR, I_WG, I_WU, I_WD, I_GFIN };

struct Frame {
    ldsp lds; int tid, lane, wave, vcu, G;
    const Params* p;
};

__device__ __forceinline__ unsigned toff(unsigned row, unsigned ch) { return 256u * row + 16u * (ch ^ (((row & 3u) << 2) | ((row >> 2) & 3u))); }
__device__ __forceinline__ float tile_el(ldscp T, int r, int c) { return bf2f(*(const LAS unsigned short*)(T + toff(r, c >> 3) + 2 * (c & 7))); }
__device__ __forceinline__ bf16x8 frag_row(ldscp T, int r0, int s, int lane) { return *(const LAS bf16x8*)(T + toff(r0 + (lane & 31), 2 * s + (lane >> 5))); }
__device__ __forceinline__ bf16x8 frag_tr(ldscp T, int c, int ks, int lane) {
    const unsigned h = lane >> 5, blk = (lane >> 4) & 1, q = (lane & 15) >> 2, p = lane & 3;
    const unsigned a0 = toff(16 * ks + 8 * h + q, 4 * c + 2 * blk + (p >> 1)) + 8 * (p & 1);
    const unsigned a1 = toff(16 * ks + 8 * h + 4 + q, 4 * c + 2 * blk + (p >> 1)) + 8 * (p & 1);
    const s16x4 lo = __builtin_bit_cast(s16x4, __builtin_amdgcn_ds_read_tr16_b64_v4i16((LAS s16x4*)(T + a0)));
    const s16x4 hi = __builtin_bit_cast(s16x4, __builtin_amdgcn_ds_read_tr16_b64_v4i16((LAS s16x4*)(T + a1)));
    return (bf16x8){lo[0], lo[1], lo[2], lo[3], hi[0], hi[1], hi[2], hi[3]};
}
template <bool TRA, bool TRB>
__device__ __forceinline__ void mm128(f32x16 (&acc)[2], ldscp TA, ldscp TB, int wave, int lane) {
    const int rb = wave >> 1, cb0 = 2 * (wave & 1);
#if NAIVE_MM
#pragma unroll
    for (int cbi = 0; cbi < 2; ++cbi) {
        const int j = 32 * (cb0 + cbi) + (lane & 31);
#pragma unroll
        for (int r = 0; r < 16; ++r) {
            const int i = 32 * rb + (r & 3) + 8 * (r >> 2) + 4 * (lane >> 5);
            float s = acc[cbi][r];
            for (int k = 0; k < 128; ++k) {
                const float a = TRA ? tile_el(TA, k, i) : tile_el(TA, i, k);
                const float b = TRB ? tile_el(TB, k, j) : tile_el(TB, j, k);
                s += a * b;
            }
            acc[cbi][r] = s;
        }
    }
#else
    const unsigned h = lane >> 5, blk = (lane >> 4) & 1, q4 = (lane & 15) >> 2, p4 = lane & 3;
    const unsigned trb0 = toff(8 * h + q4, 2 * blk + (p4 >> 1)) + 8 * (p4 & 1), trb1 = toff(8 * h + 4 + q4, 2 * blk + (p4 >> 1)) + 8 * (p4 & 1);
    const unsigned rwa = toff(32 * rb + (lane & 31), h), rwb = toff(32 * cb0 + (lane & 31), h);
#define MM_TR(T, c, ks) ({ const s16x4 lo_ = __builtin_bit_cast(s16x4, __builtin_amdgcn_ds_read_tr16_b64_v4i16((LAS s16x4*)((T) + ((trb0 ^ ((unsigned)(c) << 6)) + 4096u * (ks))))); \
                           const s16x4 hi_ = __builtin_bit_cast(s16x4, __builtin_amdgcn_ds_read_tr16_b64_v4i16((LAS s16x4*)((T) + ((trb1 ^ ((unsigned)(c) << 6)) + 4096u * (ks))))); \
                           (bf16x8){lo_[0], lo_[1], lo_[2], lo_[3], hi_[0], hi_[1], hi_[2], hi_[3]}; })
#define MM_ROW(T, base, s, extra) (*(const LAS bf16x8*)((T) + (((base) ^ ((unsigned)(s) << 5)) + (extra))))
#define MM_LDA(s) (TRA ? MM_TR(TA, rb, s) : MM_ROW(TA, rwa, s, 0u))
#define MM_LDB(s, cbi) (TRB ? MM_TR(TB, cb0 + (cbi), s) : MM_ROW(TB, rwb, s, 8192u * (cbi)))
    bf16x8 a = MM_LDA(0), b0 = MM_LDB(0, 0), b1 = MM_LDB(0, 1);
#pragma unroll
    for (int s = 0; s < 8; ++s) {
        bf16x8 an = a, b0n = b0, b1n = b1;
        if (s < 7) { an = MM_LDA(s + 1); b0n = MM_LDB(s + 1, 0); b1n = MM_LDB(s + 1, 1); }
        acc[0] = __builtin_amdgcn_mfma_f32_32x32x16_bf16(a, b0, acc[0], 0, 0, 0);
        acc[1] = __builtin_amdgcn_mfma_f32_32x32x16_bf16(a, b1, acc[1], 0, 0, 0);
        asm volatile("" ::: "memory");
        a = an; b0 = b0n; b1 = b1n;
    }
#undef MM_TR
#undef MM_ROW
#undef MM_LDA
#undef MM_LDB
#endif
}
#define ACC_ROW(rb, r, lane) (32 * (rb) + ((r) & 3) + 8 * ((r) >> 2) + 4 * ((lane) >> 5))

__device__ __forceinline__ void load_tile(ldsp T, const bf16* g, size_t pitch, int tid) {
#pragma unroll
    for (int i = 0; i < 4; ++i) { const int q = tid + 512 * i, row = q >> 4, ch = q & 15;
        const u32x4 v = *(const u32x4*)(g + (size_t)row * pitch + ch * 8);
        *(LAS u32x4*)(T + toff(row, ch)) = v; }
}
__device__ __forceinline__ void store_tile(ldscp T, bf16* g, size_t pitch, int tid) {
#pragma unroll
    for (int i = 0; i < 4; ++i) { const int q = tid + 512 * i, row = q >> 4, ch = q & 15;
        *(u32x4*)(g + (size_t)row * pitch + ch * 8) = *(const LAS u32x4*)(T + toff(row, ch)); }
}

namespace pg8 {
constexpr int BM = 256, BK = 64, HALF = 128, HTB = HALF * BK * 2, NXCD = 8, WGM = 8;
__device__ __forceinline__ int lds_byte(int r, int c) { const int st = (r >> 4) * 2 + (c >> 5), rr = r & 15, cc = c & 31, ob = rr * 64 + cc * 2; return st * 1024 + (ob ^ (((ob >> 9) & 1) << 5)); }
__device__ __forceinline__ void stage_rc(int b, int& R, int& C) { const int st = b / 1024, sb = b % 1024, swz = sb ^ (((sb >> 9) & 1) << 5); R = (st >> 1) * 16 + swz / 64; C = (st & 1) * 32 + (swz % 64) / 2; }
__device__ __forceinline__ int perm32(int rho) { const int n = rho >> 4, i = rho & 15; return 8 * (i >> 2) + 4 * n + (i & 3); }
struct Unit { int pm, pn; };
struct Gemm { const bf16* A; const bf16* Bt; int K; };
__device__ __forceinline__ int xcd_remap(int wgid, int nwg) { const int q = nwg / NXCD, r = nwg % NXCD, xcd = wgid % NXCD, off = wgid / NXCD; return (xcd < r ? xcd * (q + 1) : r * (q + 1) + (xcd - r) * q) + off; }
struct DenseOrder {
    int nM, nN, nwg, G, c;
    __device__ void init(int nM_, int nN_, int G_, int c_) { nM = nM_; nN = nN_; nwg = nM * nN; G = G_; c = c_; }
    __device__ bool map(int L, Unit& u) const {
        if (L >= nwg) return false;
        const int wgid = xcd_remap(L, nwg);
        const int nig = WGM * nN, gid = wgid / nig, fm = gid * WGM, gsz = (nM - fm) < WGM ? (nM - fm) : WGM;
        u.pm = fm + ((wgid % nig) % gsz); u.pn = (wgid % nig) / gsz; return true;
    }
    __device__ bool next(int i, Unit& u) const { return map(i * G + c, u); }
};
struct InProjOrder {
    DenseOrder d;
    __device__ void init(int G_, int c_) { d.init(64, 12, G_, c_); }
    __device__ bool next(int i, Unit& u) const {
        const int L = i * d.G + d.c;
        if (L < 768) return d.map(L, u);
        if (L < 784) { const int q = L - 768; u.pm = 64 + (q & 3); u.pn = 8 + (q >> 2); return true; }
        return false;
    }
};
struct GroupedOrder {
    int nMe, nNe, nwg, G, c;
    __device__ void init(int nMe_, int nNe_, int G_, int c_) { nMe = nMe_; nNe = nNe_; nwg = NE * nMe * nNe; G = G_; c = c_; }
    __device__ bool next(int i, Unit& u) const {
        const int L = i * G + c; if (L >= nwg) return false;
        const int wgid = xcd_remap(L, nwg), per = nMe * nNe, e = wgid / per, w = wgid % per;
        u.pm = e * nMe + (w % nMe); u.pn = e * nNe + (w / nMe); return true;
    }
};
__device__ __forceinline__ unsigned cvt_pk_bf16(float lo, float hi) { unsigned r; asm volatile("v_cvt_pk_bf16_f32 %0, %1, %2" : "=v"(r) : "v"(lo), "v"(hi)); return r; }

#if NAIVE_GEMM
template <class Epi, class Sched>
__device__ __forceinline__ void gemm_phase(ldsp lds, const Gemm g, const Sched& S, const Epi& E) {
    const int tid = threadIdx.x, wid = tid >> 6, lane = tid & 63, wr = wid >> 2, wc = wid & 3, fr = lane & 15, fq = lane >> 4;
    const int K = g.K;
    Unit u;
    for (int ui = 0; S.next(ui, u); ++ui) {
        f32x4 acc[2][2][4][2];
#pragma unroll
        for (int ai = 0; ai < 2; ++ai)
#pragma unroll
            for (int m = 0; m < 4; ++m) {
                const bf16* arow = g.A + (size_t)(u.pm * 256 + 128 * ai + 64 * wr + 16 * m + fr) * K;
#pragma unroll
                for (int bj = 0; bj < 2; ++bj)
#pragma unroll
                    for (int n = 0; n < 2; ++n) {
                        f32x4 a4 = {0.f, 0.f, 0.f, 0.f};
#pragma unroll
                        for (int j = 0; j < 4; ++j) {
                            const int col = u.pn * 256 + 128 * bj + 32 * wc + (Epi::PERM ? (8 * fq + 4 * n) : (16 * n + 4 * fq)) + j;
                            const bf16* brow = g.Bt + (size_t)col * K;
                            float s = 0.f;
                            for (int k = 0; k < K; k += 8) {
                                const u32x4 av = *(const u32x4*)(arow + k), bv = *(const u32x4*)(brow + k);
                                s += bflo(av.x) * bflo(bv.x) + bfhi(av.x) * bfhi(bv.x) + bflo(av.y) * bflo(bv.y) + bfhi(av.y) * bfhi(bv.y)
                                   + bflo(av.z) * bflo(bv.z) + bfhi(av.z) * bfhi(bv.z) + bflo(av.w) * bflo(bv.w) + bfhi(av.w) * bfhi(bv.w);
                            }
                            a4[j] = s;
                        }
                        acc[ai][bj][m][n] = a4;
                    }
            }
        E(acc, u, wr, wc, fr, fq);
    }
}
#else
template <class Epi, class Sched>
__device__ __forceinline__ void gemm_phase(ldsp lds, const Gemm g, const Sched& S, const Epi& E) {
    const int tid = threadIdx.x, wid = __builtin_amdgcn_readfirstlane(tid >> 6), lane = tid & 63, wr = wid >> 2, wc = wid & 3, fr = lane & 15, fq = lane >> 4;
    const int K = g.K, nt = K / BK;
    unsigned voffA[2], voffB[2];
#pragma unroll
    for (int i = 0; i < 2; ++i) { int R, C; stage_rc(tid * 16 + i * 8192, R, C); const int Rb = Epi::PERM ? ((R & ~31) + perm32(R & 31)) : R;
        voffA[i] = (unsigned)(R * K + C) * 2u; voffB[i] = (unsigned)(Rb * K + C) * 2u; }
    const size_t kstep = (size_t)(BK * 2);
    const size_t hstep = (size_t)HALF * K * 2;
    const size_t tstep = 2 * hstep;
    const unsigned ldsw = (unsigned)wid * 1024u;
    const int aoff = lds_byte(wr * 64 + fr, fq * 8), boff = lds_byte(wc * 32 + fr, fq * 8);
#define PG8_SA(b, h) (((b) * 2 + (h)) * HTB)
#define PG8_SB(b, h) ((4 + (b) * 2 + (h)) * HTB)
#define PG8_STAGE(bufoff, gbase, voff) do { _Pragma("unroll") for (int _i = 0; _i < 2; ++_i) \
        __builtin_amdgcn_global_load_lds((const unsigned*)((const char*)(gbase) + (voff)[_i]), (LAS unsigned*)(lds + (bufoff) + ldsw + _i * 8192), 16, 0, 0); } while (0)
#define PG8_LDA(dst, b, h) do { _Pragma("unroll") for (int m = 0; m < 4; ++m) _Pragma("unroll") for (int k = 0; k < 2; ++k) dst[m][k] = *(const LAS bf16x8*)(lds + PG8_SA(b, h) + aoff + m * 2048 + k * 1024); } while (0)
#define PG8_LDB(dst, b, h) do { _Pragma("unroll") for (int n = 0; n < 2; ++n) _Pragma("unroll") for (int k = 0; k < 2; ++k) dst[n][k] = *(const LAS bf16x8*)(lds + PG8_SB(b, h) + boff + n * 2048 + k * 1024); } while (0)
#define PG8_MMA(ai, bj, At, Bt) do { __builtin_amdgcn_s_setprio(1); _Pragma("unroll") for (int m = 0; m < 4; ++m) _Pragma("unroll") for (int n = 0; n < 2; ++n) _Pragma("unroll") for (int k = 0; k < 2; ++k) \
        acc[ai][bj][m][n] = __builtin_amdgcn_mfma_f32_16x16x32_bf16(Bt[n][k], At[m][k], acc[ai][bj][m][n], 0, 0, 0); __builtin_amdgcn_s_setprio(0); } while (0)
#define PG8_WAIT_V(n) asm volatile("s_waitcnt vmcnt(" #n ")" ::: "memory")
#define PG8_WAIT_L(n) asm volatile("s_waitcnt lgkmcnt(" #n ")" ::: "memory")
#define PG8_BAR __builtin_amdgcn_s_barrier()
#define PG8_SCHED __builtin_amdgcn_sched_barrier(0)
    Unit cur, nxt; int ui = 0;
    if (!S.next(0, cur)) return;
    f32x4 acc[2][2][4][2];
#pragma unroll
    for (int a = 0; a < 2; ++a)
#pragma unroll
        for (int b = 0; b < 2; ++b)
#pragma unroll
            for (int m = 0; m < 4; ++m)
#pragma unroll
                for (int n = 0; n < 2; ++n) acc[a][b][m][n] = (f32x4){0.f, 0.f, 0.f, 0.f};
    bf16x8 At[4][2], B0[2][2], B1[2][2];
    const char* cA = (const char*)g.A + (size_t)cur.pm * tstep; const char* cB = (const char*)g.Bt + (size_t)cur.pn * tstep;
    PG8_STAGE(PG8_SB(0, 0), cB, voffB); PG8_STAGE(PG8_SB(0, 1), cB + hstep, voffB); PG8_STAGE(PG8_SA(0, 0), cA, voffA); PG8_STAGE(PG8_SA(0, 1), cA + hstep, voffA);
    if (wr == 1) PG8_BAR;
    PG8_WAIT_V(2); PG8_BAR;
    PG8_STAGE(PG8_SB(1, 0), cB + kstep, voffB); PG8_STAGE(PG8_SA(1, 0), cA + kstep, voffA); PG8_STAGE(PG8_SB(1, 1), cB + hstep + kstep, voffB);
    PG8_WAIT_V(6); PG8_BAR;
    for (;;) {
        const bool has_next = S.next(ui + 1, nxt);
        const char* nA = has_next ? (const char*)g.A + (size_t)nxt.pm * tstep : cA; const char* nB = has_next ? (const char*)g.Bt + (size_t)nxt.pn * tstep : cB;
        for (int t = 0; t < nt; t += 2) {
            const bool last = (t == nt - 2);
            const char* a1 = cA + (size_t)(t + 1) * kstep;
            const char* a2 = last ? nA : cA + (size_t)(t + 2) * kstep; const char* b2 = last ? nB : cB + (size_t)(t + 2) * kstep;
            const char* a3 = a2 + kstep; const char* b3 = b2 + kstep;
            PG8_LDB(B0, 0, 0); PG8_LDB(B1, 0, 1); PG8_SCHED; PG8_LDA(At, 0, 0); PG8_STAGE(PG8_SA(1, 1), a1 + hstep, voffA);
            PG8_WAIT_V(8); PG8_WAIT_L(0); PG8_BAR; PG8_MMA(0, 0, At, B0); PG8_MMA(0, 1, At, B1); PG8_BAR; PG8_SCHED;
            PG8_LDA(At, 0, 1); PG8_STAGE(PG8_SB(0, 0), b2, voffB); PG8_STAGE(PG8_SB(0, 1), b2 + hstep, voffB); PG8_STAGE(PG8_SA(0, 0), a2, voffA);
            PG8_WAIT_V(8); PG8_WAIT_L(0); PG8_BAR; PG8_MMA(1, 0, At, B0); PG8_MMA(1, 1, At, B1); PG8_BAR; PG8_SCHED;
            PG8_LDB(B0, 1, 0); PG8_LDB(B1, 1, 1); PG8_SCHED; PG8_LDA(At, 1, 0); PG8_STAGE(PG8_SA(0, 1), a2 + hstep, voffA);
            PG8_WAIT_V(8); PG8_WAIT_L(0); PG8_BAR; PG8_MMA(0, 0, At, B0); PG8_MMA(0, 1, At, B1); PG8_BAR; PG8_SCHED;
            PG8_LDA(At, 1, 1); PG8_STAGE(PG8_SB(1, 0), b3, voffB); PG8_STAGE(PG8_SB(1, 1), b3 + hstep, voffB); PG8_STAGE(PG8_SA(1, 0), a3, voffA);
            PG8_WAIT_V(8); PG8_WAIT_L(0); PG8_BAR; PG8_MMA(1, 0, At, B0); PG8_MMA(1, 1, At, B1); PG8_BAR; PG8_SCHED;
        }
        if (wr == 0) PG8_BAR;
        E(acc, cur, wr, wc, fr, fq);
        if (!has_next) break;
#pragma unroll
        for (int a = 0; a < 2; ++a)
#pragma unroll
            for (int b = 0; b < 2; ++b)
#pragma unroll
                for (int m = 0; m < 4; ++m)
#pragma unroll
                    for (int n = 0; n < 2; ++n) acc[a][b][m][n] = (f32x4){0.f, 0.f, 0.f, 0.f};
        cur = nxt; cA = nA; cB = nB; ++ui;
        if (wr == 1) PG8_BAR;
    }
    PG8_WAIT_V(0);
    PG8_BAR;
#undef PG8_SA
#undef PG8_SB
#undef PG8_STAGE
#undef PG8_LDA
#undef PG8_LDB
#undef PG8_MMA
#undef PG8_WAIT_V
#undef PG8_WAIT_L
#undef PG8_BAR
#undef PG8_SCHED
}
#endif

struct EpiInProj {
    static constexpr bool PERM = true;
    bf16* P; bf16* PC;
    __device__ __forceinline__ void operator()(const f32x4 (&acc)[2][2][4][2], const Unit& u, int wr, int wc, int fr, int fq) const {
        const bool isctx = u.pm >= 64;
        const int row0 = (isctx ? (u.pm - 64) : u.pm) * BM + wr * 64 + fr;
        const int col0 = (isctx ? (u.pn - 8) : u.pn) * BM + wc * 32 + 8 * fq;
        bf16* base = isctx ? PC : P; const int ldc = isctx ? 1024 : PW;
#pragma unroll
        for (int ai = 0; ai < 2; ++ai)
#pragma unroll
            for (int m = 0; m < 4; ++m) { bf16* rowp = base + (size_t)(row0 + ai * HALF + m * 16) * ldc + col0;
#pragma unroll
                for (int bj = 0; bj < 2; ++bj) { const f32x4 v0 = acc[ai][bj][m][0], v1 = acc[ai][bj][m][1];
                    u32x4 w; w.x = cvt_pk_bf16(v0[0], v0[1]); w.y = cvt_pk_bf16(v0[2], v0[3]); w.z = cvt_pk_bf16(v1[0], v1[1]); w.w = cvt_pk_bf16(v1[2], v1[3]);
                    *(u32x4*)(rowp + bj * HALF) = w; } }
    }
};
struct EpiOut {
    static constexpr bool PERM = false;
    const float* x; float* out; const float* mod;
    __device__ __forceinline__ void operator()(const f32x4 (&acc)[2][2][4][2], const Unit& u, int wr, int wc, int fr, int fq) const {
        const int row0 = u.pm * BM + wr * 64 + fr, col0 = u.pn * BM + wc * 32 + 4 * fq;
        const int b = (u.pm * BM) / SEQ;
        f32x4 gv[2][2];
#pragma unroll
        for (int bj = 0; bj < 2; ++bj)
#pragma unroll
            for (int n = 0; n < 2; ++n) gv[bj][n] = *(const f32x4*)(mod + b * 6144 + 2048 + col0 + bj * HALF + n * 16);
#pragma unroll
        for (int ai = 0; ai < 2; ++ai)
#pragma unroll
            for (int m = 0; m < 4; ++m) { const size_t off = (size_t)(row0 + ai * HALF + m * 16) * D + col0;
#pragma unroll
                for (int bj = 0; bj < 2; ++bj)
#pragma unroll
                    for (int n = 0; n < 2; ++n) { const f32x4 xv = *(const f32x4*)(x + off + bj * HALF + n * 16);
                        *(f32x4*)(out + off + bj * HALF + n * 16) = xv + gv[bj][n] * acc[ai][bj][m][n]; } }
    }
};
struct EpiGU {
    static constexpr bool PERM = true;
    bf16* hid;
    __device__ __forceinline__ void operator()(const f32x4 (&acc)[2][2][4][2], const Unit& u, int wr, int wc, int fr, int fq) const {
        const int row0 = u.pm * BM + wr * 64 + fr, col0 = (u.pn & 15) * 128 + wc * 32 + 8 * fq;
#pragma unroll
        for (int ai = 0; ai < 2; ++ai)
#pragma unroll
            for (int m = 0; m < 4; ++m) { bf16* rowp = hid + (size_t)(row0 + ai * HALF + m * 16) * DE + col0;
                float h[8];
#pragma unroll
                for (int n = 0; n < 2; ++n)
#pragma unroll
                    for (int j = 0; j < 4; ++j) { const float a = acc[ai][0][m][n][j], up = acc[ai][1][m][n][j]; h[4 * n + j] = a / (1.f + __expf(-a)) * up; }
                u32x4 w; w.x = cvt_pk_bf16(h[0], h[1]); w.y = cvt_pk_bf16(h[2], h[3]); w.z = cvt_pk_bf16(h[4], h[5]); w.w = cvt_pk_bf16(h[6], h[7]);
                *(u32x4*)rowp = w; }
    }
};
struct EpiDown {
    static constexpr bool PERM = true;
    bf16* ye; const float* gatev;
    __device__ __forceinline__ void operator()(const f32x4 (&acc)[2][2][4][2], const Unit& u, int wr, int wc, int fr, int fq) const {
        const int row0 = u.pm * BM + wr * 64 + fr, col0 = (u.pn & 3) * BM + wc * 32 + 8 * fq;
#pragma unroll
        for (int ai = 0; ai < 2; ++ai)
#pragma unroll
            for (int m = 0; m < 4; ++m) { const int row = row0 + ai * HALF + m * 16; const float gt = gatev[row]; bf16* rowp = ye + (size_t)row * D + col0;
#pragma unroll
                for (int bj = 0; bj < 2; ++bj) { const f32x4 v0 = acc[ai][bj][m][0] * gt, v1 = acc[ai][bj][m][1] * gt;
                    u32x4 w; w.x = cvt_pk_bf16(v0[0], v0[1]); w.y = cvt_pk_bf16(v0[2], v0[3]); w.z = cvt_pk_bf16(v1[0], v1[1]); w.w = cvt_pk_bf16(v1[2], v1[3]);
                    *(u32x4*)(rowp + bj * HALF) = w; } }
    }
};
}

#define WSP(T, off) ((T*)(F.p->ws + (off)))
#define INP(i) (F.p->in[i])

__device__ __forceinline__ void transpose_item(const float* W, int K, int N, bf16* WT, int drow0, LAS float* scr, int kb, int nb, int lane) {
    const int k0 = 64 * kb, n0 = 32 * nb;
#pragma unroll 8
    for (int i = 0; i < 32; ++i) { const int kk = 2 * i + (lane >> 5); scr[kk * 33 + (lane & 31)] = W[(size_t)(k0 + kk) * N + n0 + (lane & 31)]; }
    LDS_WAIT(); asm volatile("" ::: "memory");
    const int c = lane & 7;
#pragma unroll
    for (int j = 0; j < 4; ++j) { const int n = (lane >> 3) + 8 * j; const LAS float* s = scr + (8 * c) * 33 + n;
        u32x4 o; o.x = pk2(s[0 * 33], s[1 * 33]); o.y = pk2(s[2 * 33], s[3 * 33]); o.z = pk2(s[4 * 33], s[5 * 33]); o.w = pk2(s[6 * 33], s[7 * 33]);
        *(u32x4*)(WT + (size_t)(drow0 + n) * K + k0 + 8 * c) = o; }
    LDS_WAIT(); asm volatile("" ::: "memory");
}

__device__ __forceinline__ void phase_a(Frame& F) {
    const int tid = F.tid, lane = F.lane, wave = F.wave;
    if (F.vcu < 192) {
        LAS float* sc = (LAS float*)F.lds;
        LAS float* red = (LAS float*)(F.lds + 32768);
        for (int i = tid; i < 5 * 1024; i += 512) { const int b = i >> 10, k = i & 1023; const float v = (b < 4) ? INP(I_C)[b * 1024 + k] : INP(I_CCTX)[k]; sc[i] = silu_f(v); }
        __syncthreads();
        const int n0 = 32 * F.vcu, col = lane & 31, kh = lane >> 5;
        const float* wm = INP(I_WMOD);
        float a0 = 0.f, a1 = 0.f, a2 = 0.f, a3 = 0.f, a4 = 0.f;
#pragma unroll 8
        for (int i = 0; i < 64; ++i) { const int k = wave * 128 + 2 * i + kh; const float w = wm[(size_t)k * 6144 + n0 + col];
            a0 += sc[k] * w; a1 += sc[1024 + k] * w; a2 += sc[2048 + k] * w; a3 += sc[3072 + k] * w; a4 += sc[4096 + k] * w; }
        const int slot = wave * 2 + kh;
        red[(slot * 5 + 0) * 32 + col] = a0; red[(slot * 5 + 1) * 32 + col] = a1; red[(slot * 5 + 2) * 32 + col] = a2; red[(slot * 5 + 3) * 32 + col] = a3; red[(slot * 5 + 4) * 32 + col] = a4;
        __syncthreads();
        if (tid < 160) { const int b = tid >> 5, c2 = tid & 31; float s = 0.f;
#pragma unroll
            for (int q = 0; q < 16; ++q) s += red[(q * 5 + b) * 32 + c2];
            if (b < 4 || n0 < 2048) WSP(float, WS_MOD)[b * 6144 + n0 + c2] = s + INP(I_BMOD)[n0 + c2]; }
        __syncthreads();
    }
    {
        LAS float* scr = (LAS float*)(F.lds + wave * 8704);
        const int gw = F.vcu * 8 + wave, NGW = F.G * 8;
        constexpr int I_IN = 16 * 96, I_OUT = 16 * 32, I_G = 16 * 64 * NE, I_U = I_G, I_D = 32 * 32 * NE;
        constexpr int NITEMS = I_IN + I_OUT + I_G + I_U + I_D;
        for (int it = gw; it < NITEMS; it += NGW) {
            int r = it;
            if (r < I_IN) { transpose_item(INP(I_WIN), 1024, PROJ_W, WSP(bf16, WS_WINT), 32 * (r % 96), scr, r / 96, r % 96, lane); continue; } r -= I_IN;
            if (r < I_OUT) { transpose_item(INP(I_WOUT), 1024, 1024, WSP(bf16, WS_WOUTT), 32 * (r % 32), scr, r / 32, r % 32, lane); continue; } r -= I_OUT;
            if (r < I_G + I_U) { const bool up = r >= I_G; if (up) r -= I_G; const int e = r / 1024, q = r % 1024, kb = q / 64, nb = q % 64, n0 = 32 * nb;
                const int drow = e * 4096 + 256 * (n0 >> 7) + (n0 & 127) + (up ? 128 : 0);
                transpose_item(INP(up ? I_WU : I_WG) + (size_t)e * 1024 * 2048, 1024, 2048, WSP(bf16, WS_WE1), drow, scr, kb, nb, lane); continue; } r -= I_G + I_U;
            { const int e = r / 1024, q = r % 1024, kb = q / 32, nb = q % 32;
                transpose_item(INP(I_WD) + (size_t)e * 2048 * 1024, 2048, 1024, WSP(bf16, WS_WE2), e * 1024 + 32 * nb, scr, kb, nb, lane); }
        }
        for (int i = F.vcu * 512 + tid; i < 4 * 128 * 128 / 2; i += F.G * 512) { const f32x2 v = *(const f32x2*)(INP(I_GWS) + 2 * i); WSP(unsigned, WS_WSB)[i] = pk2(v.x, v.y); }
    }
}

__device__ __forceinline__ void stage_w16(ldsp L, const float* W, int ldw, int tid) {
#pragma unroll
    for (int i = 0; i < 8; ++i) { const int q = tid + 512 * i, k = q >> 2, c = q & 3;
        *(LAS f32x4*)(L + k * 64 + 16 * (c ^ ((k >> 2) & 3))) = *(const f32x4*)(W + (size_t)k * ldw + 4 * c); }
}
template <int R>
__device__ __forceinline__ void row16(ldscp L, const float (&hv)[R][16], float (&acc)[R][16], int lane) {
#pragma unroll
    for (int r = 0; r < R; ++r)
#pragma unroll
        for (int j = 0; j < 16; ++j) acc[r][j] = 0.f;
#pragma unroll
    for (int jj = 0; jj < 16; ++jj) { const int k = lane + 64 * jj;
#pragma unroll
        for (int c = 0; c < 4; ++c) { const f32x4 w = *(const LAS f32x4*)(L + k * 64 + 16 * (c ^ ((k >> 2) & 3)));
#pragma unroll
            for (int r = 0; r < R; ++r) { acc[r][4 * c + 0] += hv[r][jj] * w[0]; acc[r][4 * c + 1] += hv[r][jj] * w[1]; acc[r][4 * c + 2] += hv[r][jj] * w[2]; acc[r][4 * c + 3] += hv[r][jj] * w[3]; } }
        asm volatile("" ::: "memory"); }
#pragma unroll
    for (int r = 0; r < R; ++r)
#pragma unroll
        for (int j = 0; j < 16; ++j) acc[r][j] = wave_sum(acc[r][j]);
}

template <int R>
__device__ __forceinline__ void pb_rows(Frame& F, const float* src, int row_dst0, const float* gm, const float* shp, const float* scp) {
    const int lane = F.lane;
    float gs[16], sh[16];
#pragma unroll
    for (int jj = 0; jj < 16; ++jj) { const int k = lane + 64 * jj; gs[jj] = gm[k] * (1.f + scp[k]); sh[jj] = shp[k]; }
    float hv[R][16];
#pragma unroll
    for (int r = 0; r < R; ++r) {
        float ss = 0.f;
#pragma unroll
        for (int jj = 0; jj < 16; ++jj) { hv[r][jj] = src[(size_t)r * D + lane + 64 * jj]; ss += hv[r][jj] * hv[r][jj]; }
        const float rr = rsqrtf(wave_sum(ss) * (1.f / D) + EPS);
        bf16* hrow = WSP(bf16, WS_H) + (size_t)(row_dst0 + r) * D;
#pragma unroll
        for (int jj = 0; jj < 16; ++jj) { hv[r][jj] = hv[r][jj] * rr * gs[jj] + sh[jj]; hrow[lane + 64 * jj] = (bf16)f2bf(hv[r][jj]); }
    }
    float acc[R][16];
    row16<R>(F.lds, hv, acc, lane);
#pragma unroll
    for (int r = 0; r < R; ++r) { float o = 0.f;
#pragma unroll
        for (int j = 0; j < 16; ++j) o = (lane == j) ? acc[r][j] : o;
        if (lane < 16) WSP(float, WS_GATES)[(size_t)(row_dst0 + r) * 16 + lane] = o; }
}
__device__ __forceinline__ void phase_b(Frame& F) {
    stage_w16(F.lds, INP(I_WIN) + PW, PROJ_W, F.tid);
    __syncthreads();
    const int gw = F.vcu * 8 + F.wave;
    const float* mod = WSP(float, WS_MOD);
    { const int row0 = gw * 8, b = row0 / SEQ;
      pb_rows<4>(F, INP(I_X) + (size_t)row0 * D, row0, INP(I_GMIX), mod + b * 6144, mod + b * 6144 + 1024);
      pb_rows<4>(F, INP(I_X) + (size_t)(row0 + 4) * D, row0 + 4, INP(I_GMIX), mod + b * 6144, mod + b * 6144 + 1024); }
    if (gw < NCTX) pb_rows<1>(F, INP(I_CTX) + (size_t)gw * D, NLAT + gw, INP(I_GMIX), mod + 4 * 6144, mod + 4 * 6144 + 1024);
    __syncthreads();
}

__device__ __forceinline__ void phase_c(Frame& F) {
    pg8::Gemm g{WSP(bf16, WS_H), WSP(bf16, WS_WINT), 1024};
    pg8::InProjOrder S; S.init(F.G, (int)blockIdx.x);
    pg8::EpiInProj E{WSP(bf16, WS_P), WSP(bf16, WS_PCTX)};
    pg8::gemm_phase(F.lds, g, S, E);
}

__device__ __forceinline__ void gate_tables(Frame& F, const float* gates_row0, int h, float mprevF, float mprevB) {
    LAS float* T = (LAS float*)(F.lds + TAB_OFF);
    const int tid = F.tid;
    if (tid < 128) {
        const float* gr = gates_row0 + (size_t)tid * 16;
        const float bi0 = INP(I_BI)[h], bi1 = INP(I_BI)[4 + h], bf0 = INP(I_BF)[h], bf1 = INP(I_BF)[4 + h];
        T[tid] = gr[h] + bi0; T[128 + tid] = logsig_f(gr[8 + h] + bf0);
        T[256 + tid] = gr[4 + h] + bi1; T[384 + tid] = logsig_f(gr[12 + h] + bf1);
    }
    __syncthreads();
    if (tid == 0) {
        float bc = 0.f, um = -INFINITY;
        for (int s = 0; s < 128; ++s) { bc += T[128 + s]; const float u = T[s] - bc; um = fmaxf(um, u); T[512 + s] = u; T[640 + s] = fmaxf(mprevF, um); T[1152 + s] = bc; }
        T[1024] = bc; T[1025] = um; T[1028] = mprevF;
    }
    if (tid == 64) {
        float rc = 0.f, um = -INFINITY;
        for (int s = 127; s >= 0; --s) { rc += T[384 + s]; const float u = T[256 + s] - rc; um = fmaxf(um, u); T[768 + s] = u; T[896 + s] = fmaxf(mprevB, um); T[1280 + s] = rc; }
        T[1026] = rc; T[1027] = um; T[1029] = mprevB;
    }
    __syncthreads();
}

__device__ __forceinline__ void conv_silu8(const bf16* base, size_t pitch, int spos, int seqlen, const float* cw  , float scale, float (&o)[8]) {
    const u32x4 z = {0u, 0u, 0u, 0u};
    const u32x4 v0 = (spos > 0) ? *(const u32x4*)(base - pitch) : z;
    const u32x4 v1 = *(const u32x4*)(base);
    const u32x4 v2 = (spos + 1 < seqlen) ? *(const u32x4*)(base + pitch) : z;
    const f32x4 w0a = *(const f32x4*)(cw), w0b = *(const f32x4*)(cw + 4), w1a = *(const f32x4*)(cw + 512), w1b = *(const f32x4*)(cw + 516), w2a = *(const f32x4*)(cw + 1024), w2b = *(const f32x4*)(cw + 1028);
    const float x0[8] = {bflo(v0.x), bfhi(v0.x), bflo(v0.y), bfhi(v0.y), bflo(v0.z), bfhi(v0.z), bflo(v0.w), bfhi(v0.w)};
    const float x1[8] = {bflo(v1.x), bfhi(v1.x), bflo(v1.y), bfhi(v1.y), bflo(v1.z), bfhi(v1.z), bflo(v1.w), bfhi(v1.w)};
    const float x2[8] = {bflo(v2.x), bfhi(v2.x), bflo(v2.y), bfhi(v2.y), bflo(v2.z), bfhi(v2.z), bflo(v2.w), bfhi(v2.w)};
    const float w0[8] = {w0a[0], w0a[1], w0a[2], w0a[3], w0b[0], w0b[1], w0b[2], w0b[3]};
    const float w1[8] = {w1a[0], w1a[1], w1a[2], w1a[3], w1b[0], w1b[1], w1b[2], w1b[3]};
    const float w2[8] = {w2a[0], w2a[1], w2a[2], w2a[3], w2b[0], w2b[1], w2b[2], w2b[3]};
#pragma unroll
    for (int e = 0; e < 8; ++e) o[e] = silu_f(x0[e] * w0[e] + x1[e] * w1[e] + x2[e] * w2[e]) * scale;
}

__device__ __forceinline__ void pd_mlstm_item(Frame& F, int it) {
    int tid = F.tid, lane = F.lane; const int wave = F.wave;
    asm volatile("" : "+v"(tid), "+v"(lane));
    int b, h, c, seqlen, jf, jb; const bf16* kbase; const bf16* vbase; size_t pitch; const float* grow;
    if (it < 512) { b = it >> 7; h = (it >> 5) & 3; c = it & 31; seqlen = SEQ; pitch = PW;
        const size_t row0 = (size_t)b * SEQ + c * 128; kbase = WSP(bf16, WS_P) + row0 * PW + 2048 + h * 128; vbase = kbase + 512;
        grow = WSP(float, WS_GATES) + row0 * 16; jf = 2 + c; jb = 2 + (31 - c); }
    else { const int q = it - 512; b = q >> 3; h = (q >> 1) & 3; c = q & 1; seqlen = CTXL; pitch = 1024;
        const size_t row0 = (size_t)b * CTXL + c * 128; kbase = WSP(bf16, WS_PCTX) + row0 * 1024 + h * 128; vbase = kbase + 512;
        grow = WSP(float, WS_GATES) + ((size_t)NLAT + row0) * 16; jf = c; jb = 1 - c; }
    gate_tables(F, grow, h, 0.f, 0.f);
    LAS float* T = (LAS float*)(F.lds + TAB_OFF);
    const float umF = T[1025], umB = T[1027];
    ldsp TV = F.lds, TKF = F.lds + TILE_BYTES, TKB = F.lds + 2 * TILE_BYTES;
    load_tile(TV, vbase, pitch, tid);
#pragma unroll 1
    for (int i = 0; i < 4; ++i) { const int q = tid + 512 * i, s = q >> 4, ch = q & 15;
        float kk[8]; conv_silu8(kbase + (size_t)s * pitch + ch * 8, pitch, c * 128 + s, seqlen, INP(I_CONVK) + h * 128 + ch * 8, 0.08838834764831845f, kk);
        const float wf = __expf(T[512 + s] - umF), wb = __expf(T[768 + s] - umB);
        u32x4 of, ob;
        of.x = pk2(kk[0] * wf, kk[1] * wf); of.y = pk2(kk[2] * wf, kk[3] * wf); of.z = pk2(kk[4] * wf, kk[5] * wf); of.w = pk2(kk[6] * wf, kk[7] * wf);
        ob.x = pk2(kk[0] * wb, kk[1] * wb); ob.y = pk2(kk[2] * wb, kk[3] * wb); ob.z = pk2(kk[4] * wb, kk[5] * wb); ob.w = pk2(kk[6] * wb, kk[7] * wb);
        *(LAS u32x4*)(TKF + toff(s, ch)) = of; *(LAS u32x4*)(TKB + toff(s, ch)) = ob; }
    __syncthreads();
    const int scanF = (b * 4 + h) * 2, scanB = scanF + 1;
    const size_t slotF = (size_t)scanF * NSTEP + jf, slotB = (size_t)scanB * NSTEP + jb;
    if (tid == 0) { float* sc = WSP(float, WS_SC); sc[slotF * 2] = T[1024]; sc[slotF * 2 + 1] = T[1025]; sc[slotB * 2] = T[1026]; sc[slotB * 2 + 1] = T[1027]; }
    if (tid < 256) { const int dir = tid >> 7, d = tid & 127; ldscp TK = dir ? TKB : TKF; float s = 0.f;
#pragma unroll 4
        for (int q = 0; q < 128; ++q) s += tile_el(TK, q, d);
        WSP(float, WS_DN)[(dir ? slotB : slotF) * 128 + d] = s; }
    const int rb = wave >> 1, cb0 = 2 * (wave & 1);
#pragma unroll
    for (int dir = 0; dir < 2; ++dir) {
        f32x16 acc[2]; acc[0] = (f32x16)(0.f); acc[1] = (f32x16)(0.f);
        mm128<true, true>(acc, TV, dir ? TKB : TKF, wave, lane);
        float* dc = WSP(float, WS_DC) + (dir ? slotB : slotF) * 16384;
#pragma unroll
        for (int cbi = 0; cbi < 2; ++cbi)
#pragma unroll
            for (int r = 0; r < 16; ++r) dc[ACC_ROW(rb, r, lane) * 128 + 32 * (cb0 + cbi) + (lane & 31)] = acc[cbi][r];
    }
    __syncthreads();
}
__device__ __forceinline__ void pd_gmlp_item(Frame& F, int it) {
    int tid = F.tid, lane = F.lane; const int wave = F.wave;
    asm volatile("" : "+v"(tid), "+v"(lane));
    const int b = it >> 7, c = (it >> 2) & 31, h = it & 3;
    const size_t row0 = (size_t)b * SEQ + c * 128;
    const bf16* P = WSP(bf16, WS_P);
    ldsp TA = F.lds, TV = F.lds + TILE_BYTES, TO = F.lds + 2 * TILE_BYTES;
    load_tile(TA, WSP(bf16, WS_WSB) + h * 16384, 128, tid);
    {
        const int q = tid >> 2, part = tid & 3;
        const bf16* vr = P + (row0 + q) * PW + 512 + part * 128;
        float s1 = 0.f, s2 = 0.f;
#pragma unroll 4
        for (int i = 0; i < 16; ++i) { const u32x4 v = *(const u32x4*)(vr + 8 * i);
            const float g0 = gelu_f(bflo(v.x)), g1 = gelu_f(bfhi(v.x)), g2 = gelu_f(bflo(v.y)), g3 = gelu_f(bfhi(v.y)), g4 = gelu_f(bflo(v.z)), g5 = gelu_f(bfhi(v.z)), g6 = gelu_f(bflo(v.w)), g7 = gelu_f(bfhi(v.w));
            s1 += ((g0 + g1) + (g2 + g3)) + ((g4 + g5) + (g6 + g7));
            s2 += ((g0 * g0 + g1 * g1) + (g2 * g2 + g3 * g3)) + ((g4 * g4 + g5 * g5) + (g6 * g6 + g7 * g7)); }
        s1 += __shfl_xor(s1, 1); s1 += __shfl_xor(s1, 2); s2 += __shfl_xor(s2, 1); s2 += __shfl_xor(s2, 2);
        const float mu = s1 * (1.f / 512.f), var = fmaxf(s2 * (1.f / 512.f) - mu * mu, 0.f), rstd = rsqrtf(var + EPS);
        const bf16* hr = P + (row0 + q) * PW + 512 + h * 128 + part * 32;
#pragma unroll
        for (int i = 0; i < 4; ++i) { const u32x4 v = *(const u32x4*)(hr + 8 * i);
            u32x4 o;
            o.x = pk2((gelu_f(bflo(v.x)) - mu) * rstd, (gelu_f(bfhi(v.x)) - mu) * rstd); o.y = pk2((gelu_f(bflo(v.y)) - mu) * rstd, (gelu_f(bfhi(v.y)) - mu) * rstd);
            o.z = pk2((gelu_f(bflo(v.z)) - mu) * rstd, (gelu_f(bfhi(v.z)) - mu) * rstd); o.w = pk2((gelu_f(bflo(v.w)) - mu) * rstd, (gelu_f(bfhi(v.w)) - mu) * rstd);
            *(LAS u32x4*)(TV + toff(q, part * 4 + i)) = o; }
    }
    __syncthreads();
    f32x16 acc[2]; acc[0] = (f32x16)(0.f); acc[1] = (f32x16)(0.f);
    mm128<false, true>(acc, TA, TV, wave, lane);
    const int rb = wave >> 1, cb0 = 2 * (wave & 1);
#pragma unroll
    for (int cbi = 0; cbi < 2; ++cbi)
#pragma unroll
        for (int r = 0; r < 16; ++r) { const int p = ACC_ROW(rb, r, lane), d = 32 * (cb0 + cbi) + (lane & 31);
            const float u = gelu_f(bf2f(P[(row0 + p) * PW + h * 128 + d]));
            const float y = u * (acc[cbi][r] + INP(I_GBS)[h * 128 + p]);
            *(LAS unsigned short*)(TO + toff(p, d >> 3) + 2 * (d & 7)) = (unsigned short)f2bf(y); }
    __syncthreads();
    store_tile(TO, WSP(bf16, WS_YMIX) + row0 * D + h * 128, D, tid);
    __syncthreads();
}
__device__ __forceinline__ void phase_d(Frame& F) {
    int it = F.vcu;
#pragma unroll 1
    for (; it < 544; it += F.G) pd_mlstm_item(F, it);
    asm volatile("" ::: "memory");
#pragma unroll 1
    for (; it < 544 + 512; it += F.G) pd_gmlp_item(F, it - 544);
}

__device__ __forceinline__ void phase_e(Frame& F) {
    const int tid = F.tid, scan = F.vcu >> 3, slice = F.vcu & 7;
    if (F.vcu >= 256) return;
    const float* sc = WSP(float, WS_SC) + (size_t)scan * NSTEP * 2;
    const int v = slice * 16 + (tid >> 5), d = (tid & 31) * 4;
    const float* dc = WSP(float, WS_DC) + (size_t)scan * NSTEP * 16384 + v * 128 + d;
    const float* dn = WSP(float, WS_DN) + (size_t)scan * NSTEP * 128;
    bf16* cst = WSP(bf16, WS_CST) + (size_t)scan * 32 * 16384 + v * 128 + d;
    f32x4 C = {0.f, 0.f, 0.f, 0.f}; float n = 0.f, m = 0.f;
    for (int j = 0; j <= 32; ++j) {
        const float BL = sc[2 * j], UM = sc[2 * j + 1];
        const float M = fmaxf(m, UM), a = __expf(m - M), bb = __expf(UM - M);
        const f32x4 dcv = *(const f32x4*)(dc + (size_t)j * 16384);
        C = C * a + dcv * bb;
        if (slice == 0 && tid < 128) n = n * a + dn[j * 128 + tid] * bb;
        m = BL + M;
        if (j >= 1) {
            u32x2 o; o.x = pk2(C[0], C[1]); o.y = pk2(C[2], C[3]);
            *(u32x2*)(cst + (size_t)(j - 1) * 16384) = o;
            if (slice == 0 && tid < 128) WSP(float, WS_NST)[((size_t)scan * 32 + (j - 1)) * 128 + tid] = n;
            if (slice == 0 && tid == 0) WSP(float, WS_MST)[scan * 32 + (j - 1)] = m;
        }
    }
}

__device__ __forceinline__ void pf_item(Frame& F, int it) {
    int tid = F.tid, lane = F.lane; const int wave = F.wave;
    asm volatile("" : "+v"(tid), "+v"(lane));
    const int b = it >> 7, h = (it >> 5) & 3, c = it & 31;
    const size_t row0 = (size_t)b * SEQ + c * 128;
    const bf16* P = WSP(bf16, WS_P);
    const int scanF = (b * 4 + h) * 2, scanB = scanF + 1, stF = c, stB = 31 - c;
    const float mpF = WSP(float, WS_MST)[scanF * 32 + stF], mpB = WSP(float, WS_MST)[scanB * 32 + stB];
    gate_tables(F, WSP(float, WS_GATES) + row0 * 16, h, mpF, mpB);
    LAS float* T = (LAS float*)(F.lds + TAB_OFF);
    if (tid < 256) { const int dir = tid >> 7, d = tid & 127; T[1408 + tid] = WSP(float, WS_NST)[((size_t)(dir ? scanB : scanF) * 32 + (dir ? stB : stF)) * 128 + d]; }
    ldsp TQ = F.lds, TX = F.lds + TILE_BYTES, TV = F.lds + 2 * TILE_BYTES, TY = F.lds + 3 * TILE_BYTES;
    load_tile(TV, P + row0 * PW + 2560 + h * 128, PW, tid);
#pragma unroll 1
    for (int i = 0; i < 4; ++i) { const int q = tid + 512 * i, s = q >> 4, ch = q & 15;
        float qq[8], kk[8];
        conv_silu8(P + (row0 + s) * PW + 1024 + h * 128 + ch * 8, PW, c * 128 + s, SEQ, INP(I_CONVQ) + h * 128 + ch * 8, 1.f, qq);
        conv_silu8(P + (row0 + s) * PW + 2048 + h * 128 + ch * 8, PW, c * 128 + s, SEQ, INP(I_CONVK) + h * 128 + ch * 8, 0.08838834764831845f, kk);
        u32x4 oq, ok;
        oq.x = pk2(qq[0], qq[1]); oq.y = pk2(qq[2], qq[3]); oq.z = pk2(qq[4], qq[5]); oq.w = pk2(qq[6], qq[7]);
        ok.x = pk2(kk[0], kk[1]); ok.y = pk2(kk[2], kk[3]); ok.z = pk2(kk[4], kk[5]); ok.w = pk2(kk[6], kk[7]);
        *(LAS u32x4*)(TQ + toff(s, ch)) = oq; *(LAS u32x4*)(TX + toff(s, ch)) = ok; }
    __syncthreads();
    const int rb = wave >> 1, cb0 = 2 * (wave & 1);
    f32x16 qk[2]; qk[0] = (f32x16)(0.f); qk[1] = (f32x16)(0.f);
    mm128<false, false>(qk, TQ, TX, wave, lane);
    __syncthreads();
    f32x16 hacc[2]; hacc[0] = (f32x16)(0.f); hacc[1] = (f32x16)(0.f);
#pragma unroll 1
    for (int dir = 0; dir < 2; ++dir) {
        const int uo = dir ? 768 : 512, mo = dir ? 896 : 640;
        int lane2 = lane; asm volatile("" : "+v"(lane2));
#pragma unroll
        for (int cbi = 0; cbi < 2; ++cbi)
#pragma unroll
            for (int r = 0; r < 16; ++r) { const int t = ACC_ROW(rb, r, lane2), s = 32 * (cb0 + cbi) + (lane2 & 31);
                const bool keep = dir ? (s >= t) : (s <= t);
                const float pv = keep ? qk[cbi][r] * __expf(T[uo + s] - T[mo + t]) : 0.f;
                *(LAS unsigned short*)(TX + toff(t, s >> 3) + 2 * (s & 7)) = (unsigned short)f2bf(pv);
                if ((r & 3) == 3) asm volatile("" ::: "memory"); }
        load_tile(TY, WSP(bf16, WS_CST) + ((size_t)(dir ? scanB : scanF) * 32 + (dir ? stB : stF)) * 16384, 128, tid);
        __syncthreads();
        { const int t = tid >> 2, part = tid & 3; float s1 = 0.f, s2 = 0.f;
#pragma unroll 4
          for (int i = 0; i < 32; ++i) { const int cc = part * 32 + i; s1 += tile_el(TX, t, cc); s2 += tile_el(TQ, t, cc) * T[(dir ? 1536 : 1408) + cc]; }
          s1 += __shfl_xor(s1, 1); s1 += __shfl_xor(s1, 2); s2 += __shfl_xor(s2, 1); s2 += __shfl_xor(s2, 2);
          const float mp = dir ? mpB : mpF, Mt = T[mo + t], inter = __expf(mp - Mt), cum = T[(dir ? 1280 : 1152) + t];
          const float den = inter * s2 + s1, flo = __expf(-cum - Mt);
          if (part == 0) T[(dir ? 1792 : 1664) + t] = fmaxf(fabsf(den), flo); }
        f32x16 acc[2]; acc[0] = (f32x16)(0.f); acc[1] = (f32x16)(0.f);
        mm128<false, false>(acc, TQ, TY, wave, lane);
        { const float mp = dir ? mpB : mpF;
#pragma unroll
          for (int r = 0; r < 16; ++r) { const float inter = __expf(mp - T[mo + ACC_ROW(rb, r, lane)]); acc[0][r] *= inter; acc[1][r] *= inter; } }
        mm128<false, true>(acc, TX, TV, wave, lane);
        __syncthreads();
#pragma unroll
        for (int r = 0; r < 16; ++r) { const float inv = 1.f / T[(dir ? 1792 : 1664) + ACC_ROW(rb, r, lane)]; hacc[0][r] += acc[0][r] * inv; hacc[1][r] += acc[1][r] * inv; }
    }
    LAS float* HB = (LAS float*)TX;
#pragma unroll
    for (int cbi = 0; cbi < 2; ++cbi)
#pragma unroll
        for (int r = 0; r < 16; ++r) HB[ACC_ROW(rb, r, lane) * 132 + 32 * (cb0 + cbi) + (lane & 31)] = hacc[cbi][r];
    __syncthreads();
    { const int t = tid >> 2, part = tid & 3; float x[32]; float s1 = 0.f;
#pragma unroll
      for (int i = 0; i < 8; ++i) { const f32x4 v = *(const LAS f32x4*)(HB + t * 132 + part * 32 + 4 * i); x[4 * i] = v[0]; x[4 * i + 1] = v[1]; x[4 * i + 2] = v[2]; x[4 * i + 3] = v[3]; s1 += (v[0] + v[1]) + (v[2] + v[3]); }
      s1 += __shfl_xor(s1, 1); s1 += __shfl_xor(s1, 2);
      const float mu = s1 * (1.f / 128.f); float s2 = 0.f;
#pragma unroll
      for (int i = 0; i < 32; ++i) { x[i] -= mu; s2 += x[i] * x[i]; }
      s2 += __shfl_xor(s2, 1); s2 += __shfl_xor(s2, 2);
      const float rstd = rsqrtf(s2 * (1.f / 128.f) + EPS);
      const bf16* orow = P + (row0 + t) * PW + 1536 + h * 128 + part * 32;
      const float* ng = INP(I_MNG) + h * 128 + part * 32;
      bf16* yrow = WSP(bf16, WS_YMIX) + (row0 + t) * D + 512 + h * 128 + part * 32;
#pragma unroll
      for (int i = 0; i < 4; ++i) { const u32x4 ov = *(const u32x4*)(orow + 8 * i); const f32x4 g0 = *(const f32x4*)(ng + 8 * i), g1 = *(const f32x4*)(ng + 8 * i + 4);
          const float y0 = x[8 * i] * rstd * g0[0] * sigmoid_f(bflo(ov.x)), y1 = x[8 * i + 1] * rstd * g0[1] * sigmoid_f(bfhi(ov.x));
          const float y2 = x[8 * i + 2] * rstd * g0[2] * sigmoid_f(bflo(ov.y)), y3 = x[8 * i + 3] * rstd * g0[3] * sigmoid_f(bfhi(ov.y));
          const float y4 = x[8 * i + 4] * rstd * g1[0] * sigmoid_f(bflo(ov.z)), y5 = x[8 * i + 5] * rstd * g1[1] * sigmoid_f(bfhi(ov.z));
          const float y6 = x[8 * i + 6] * rstd * g1[2] * sigmoid_f(bflo(ov.w)), y7 = x[8 * i + 7] * rstd * g1[3] * sigmoid_f(bfhi(ov.w));
          u32x4 o; o.x = pk2(y0, y1); o.y = pk2(y2, y3); o.z = pk2(y4, y5); o.w = pk2(y6, y7);
          *(u32x4*)(yrow + 8 * i) = o; } }
    __syncthreads();
}
__device__ __forceinline__ void phase_f(Frame& F) { for (int it = F.vcu; it < 512; it += F.G) pf_item(F, it); }

__device__ __forceinline__ void phase_g(Frame& F) {
    pg8::Gemm g{WSP(bf16, WS_YMIX), WSP(bf16, WS_WOUTT), 1024};
    pg8::DenseOrder S; S.init(64, 4, F.G, (int)blockIdx.x);
    pg8::EpiOut E{INP(I_X), F.p->out, WSP(float, WS_MOD)};
    pg8::gemm_phase(F.lds, g, S, E);
}

__device__ __forceinline__ void ph_rows4(Frame& F, int row0, int b) {
    const int lane = F.lane;
    const float* mod = WSP(float, WS_MOD) + b * 6144;
    float gs[16], sh[16];
#pragma unroll
    for (int jj = 0; jj < 16; ++jj) { const int k = lane + 64 * jj; gs[jj] = INP(I_GFFN)[k] * (1.f + mod[4096 + k]); sh[jj] = mod[3072 + k]; }
    float hv[4][16];
#pragma unroll
    for (int r = 0; r < 4; ++r) {
        const float* src = F.p->out + (size_t)(row0 + r) * D; float ss = 0.f;
#pragma unroll
        for (int jj = 0; jj < 16; ++jj) { hv[r][jj] = src[lane + 64 * jj]; ss += hv[r][jj] * hv[r][jj]; }
        const float rr = rsqrtf(wave_sum(ss) * (1.f / D) + EPS);
        bf16* hrow = WSP(bf16, WS_H) + (size_t)(row0 + r) * D;
#pragma unroll
        for (int jj = 0; jj < 16; ++jj) { hv[r][jj] = hv[r][jj] * rr * gs[jj] + sh[jj]; hrow[lane + 64 * jj] = (bf16)f2bf(hv[r][jj]); }
    }
    float acc[4][16];
    row16<4>(F.lds, hv, acc, lane);
#pragma unroll
    for (int r = 0; r < 4; ++r) {
        float mx = acc[r][0];
#pragma unroll
        for (int j = 1; j < 16; ++j) mx = fmaxf(mx, acc[r][j]);
        float sum = 0.f, o = 0.f;
#pragma unroll
        for (int j = 0; j < 16; ++j) { acc[r][j] = __expf(acc[r][j] - mx); sum += acc[r][j]; }
        const float inv = 1.f / sum;
#pragma unroll
        for (int j = 0; j < 16; ++j) o = (lane == j) ? acc[r][j] * inv : o;
        const int t = (row0 + r) & (SEQ - 1);
        if (lane < 16) WSP(float, WS_AFFT)[((size_t)b * 16 + lane) * SEQ + t] = o;
    }
}
__device__ __forceinline__ void phase_h(Frame& F) {
    stage_w16(F.lds, INP(I_WR), 16, F.tid);
    __syncthreads();
    const int gw = F.vcu * 8 + F.wave, row0 = gw * 8, b = row0 / SEQ;
    ph_rows4(F, row0, b); ph_rows4(F, row0 + 4, b);
    __syncthreads();
}

__device__ __forceinline__ void phase_i(Frame& F) {
    const int tid = F.tid, lane = F.lane, wave = F.wave;
    if (F.vcu >= 64) return;
    const int b = F.vcu >> 4, e = F.vcu & 15;
    LAS unsigned* hist = (LAS unsigned*)F.lds;
    LAS unsigned* hist2 = hist + 256;
    LAS unsigned* sel = hist + 512;
    LAS unsigned* wsum = hist + 520;
    LAS int* lidx = (LAS int*)(F.lds + 4096);
    const float* aff = WSP(float, WS_AFFT) + ((size_t)b * 16 + e) * SEQ;
    unsigned key[8];
    { const u32x4 v0 = *(const u32x4*)(aff + tid * 8), v1 = *(const u32x4*)(aff + tid * 8 + 4); key[0] = v0.x; key[1] = v0.y; key[2] = v0.z; key[3] = v0.w; key[4] = v1.x; key[5] = v1.y; key[6] = v1.z; key[7] = v1.w; }
    unsigned prefix = 0u, mask = 0u, need = CAP;
    for (int pass = 3; pass >= 0; --pass) {
        const int shift = 8 * pass;
        if (tid < 256) hist[tid] = 0u;
        __syncthreads();
#pragma unroll
        for (int i = 0; i < 8; ++i) if ((key[i] & mask) == prefix) atomicAdd((unsigned*)&hist[(key[i] >> shift) & 255u], 1u);
        __syncthreads();
        LAS unsigned* A = hist; LAS unsigned* Bv = hist2;
        for (int ofs = 1; ofs < 256; ofs <<= 1) {
            if (tid < 256) Bv[tid] = A[tid] + ((tid + ofs < 256) ? A[tid + ofs] : 0u);
            __syncthreads();
            LAS unsigned* tsw = A; A = Bv; Bv = tsw;
        }
        if (tid < 256) { const unsigned sb = A[tid], sn = (tid < 255) ? A[tid + 1] : 0u; if (sb >= need && sn < need) { sel[0] = (unsigned)tid; sel[1] = need - sn; } }
        __syncthreads();
        prefix |= sel[0] << shift; mask |= 255u << shift; need = sel[1];
        __syncthreads();
    }
    int cg = 0, ce = 0;
#pragma unroll
    for (int i = 0; i < 8; ++i) { cg += (key[i] > prefix) ? 1 : 0; ce += (key[i] == prefix) ? 1 : 0; }
    int sg = cg, se = ce;
#pragma unroll
    for (int o = 1; o < 64; o <<= 1) { const int tg = __shfl_up(sg, o), te = __shfl_up(se, o); if (lane >= o) { sg += tg; se += te; } }
    if (lane == 63) { wsum[wave] = (unsigned)sg; wsum[8 + wave] = (unsigned)se; }
    __syncthreads();
    int baseg = 0, basee = 0, totg = 0;
#pragma unroll
    for (int w = 0; w < 8; ++w) { const int g = (int)wsum[w], q = (int)wsum[8 + w]; if (w < wave) { baseg += g; basee += q; } totg += g; }
    int pg = baseg + sg - cg, pe = basee + se - ce;
    int* slotmap = WSP(int, WS_SLOT) + ((size_t)b * SEQ + tid * 8) * 16 + e;
    float* gatev = WSP(float, WS_GATEV) + ((size_t)e * 4 + b) * CAP;
#pragma unroll
    for (int i = 0; i < 8; ++i) {
        int slot = -1;
        if (key[i] > prefix) slot = pg++;
        else if (key[i] == prefix) { if (pe < (int)need) slot = totg + pe; ++pe; }
        slotmap[i * 16] = slot;
        if (slot >= 0) { lidx[slot] = tid * 8 + i; gatev[slot] = __builtin_bit_cast(float, key[i]); }
    }
    __syncthreads();
    const bf16* H2 = WSP(bf16, WS_H) + (size_t)b * SEQ * D;
    bf16* XE = WSP(bf16, WS_XE) + ((size_t)e * 4 + b) * CAP * D;
    for (int slot = wave; slot < CAP; slot += 8) { const int t = lidx[slot];
        const u32x4* src = (const u32x4*)(H2 + (size_t)t * D); u32x4* dst = (u32x4*)(XE + (size_t)slot * D);
        const u32x4 v0 = src[lane], v1 = src[lane + 64]; dst[lane] = v0; dst[lane + 64] = v1; }
    __syncthreads();
}

__device__ __forceinline__ void phase_j(Frame& F) {
    pg8::Gemm g{WSP(bf16, WS_XE), WSP(bf16, WS_WE1), 1024};
    pg8::GroupedOrder S; S.init(8, 16, F.G, (int)blockIdx.x);
    pg8::EpiGU E{WSP(bf16, WS_HID)};
    pg8::gemm_phase(F.lds, g, S, E);
}
__device__ __forceinline__ void phase_k(Frame& F) {
    pg8::Gemm g{WSP(bf16, WS_HID), WSP(bf16, WS_WE2), 2048};
    pg8::GroupedOrder S; S.init(8, 4, F.G, (int)blockIdx.x);
    pg8::EpiDown E{WSP(bf16, WS_YE), WSP(float, WS_GATEV)};
    pg8::gemm_phase(F.lds, g, S, E);
}

__device__ __forceinline__ void phase_l(Frame& F) {
    const int lane = F.lane, gw = F.vcu * 8 + F.wave;
    const float* mod = WSP(float, WS_MOD);
    for (int rr = 0; rr < 8; ++rr) {
        const int row = gw * 8 + rr, b = row / SEQ;
        float* xr = F.p->out + (size_t)row * D;
        f32x4 x[4], a[4];
#pragma unroll
        for (int j = 0; j < 4; ++j) { x[j] = *(const f32x4*)(xr + 4 * lane + 256 * j); a[j] = (f32x4){0.f, 0.f, 0.f, 0.f}; }
        const int sl = (lane < 16) ? WSP(int, WS_SLOT)[(size_t)row * 16 + lane] : -1;
        for (int e = 0; e < NE; ++e) {
            const int s = __shfl(sl, e);
            if (s >= 0) { const bf16* yr = WSP(bf16, WS_YE) + (((size_t)e * 4 + b) * CAP + s) * D;
#pragma unroll
                for (int j = 0; j < 4; ++j) { const u32x2 v = *(const u32x2*)(yr + 4 * lane + 256 * j); a[j][0] += bflo(v.x); a[j][1] += bfhi(v.x); a[j][2] += bflo(v.y); a[j][3] += bfhi(v.y); } }
        }
        float ss = 0.f;
#pragma unroll
        for (int j = 0; j < 4; ++j) { const f32x4 g2 = *(const f32x4*)(mod + b * 6144 + 5120 + 4 * lane + 256 * j); x[j] = x[j] + g2 * a[j]; ss += (x[j][0] * x[j][0] + x[j][1] * x[j][1]) + (x[j][2] * x[j][2] + x[j][3] * x[j][3]); }
        const float r = rsqrtf(wave_sum(ss) * (1.f / D) + EPS);
#pragma unroll
        for (int j = 0; j < 4; ++j) { const f32x4 fg = *(const f32x4*)(INP(I_GFIN) + 4 * lane + 256 * j); *(f32x4*)(xr + 4 * lane + 256 * j) = x[j] * r * fg; }
    }
}

__global__ void __launch_bounds__(512, 2) mk_fwd(Params prm) {
    extern __shared__ __attribute__((aligned(16))) unsigned char lds_raw[];
    Frame F;
    F.lds = (ldsp)lds_raw; F.tid = threadIdx.x; F.lane = F.tid & 63; F.wave = __builtin_amdgcn_readfirstlane(F.tid >> 6);
    F.G = gridDim.x; { const int bx = blockIdx.x; F.vcu = (F.G % 8 == 0) ? (bx % 8) * (F.G / 8) + bx / 8 : bx; }
    F.p = &prm;
    volatile LAS unsigned* MISC = (volatile LAS unsigned*)(F.lds + MISC_OFF);
    if (F.tid < 32) MISC[F.tid] = 0u;
    __syncthreads();
    const int lo = prm.ph_lo, hi = prm.ph_hi;
    XcdBarrier bar; bar.bar = (unsigned*)(prm.ws + WS_CTL) + 1024; bar.x = 0; bar.st = nullptr;
    if (hi - lo > 1) bar = xcd_barrier_post((unsigned*)(prm.ws + WS_CTL) + 1024, MISC + 8);
#ifdef ONLY_PHASE
#define IN(k) ((k) == ONLY_PHASE && lo <= (k) && (k) < hi)
#else
#define IN(k) (lo <= (k) && (k) < hi)
#endif
#define SEAM(k) do { if (IN(k) && IN((k) + 1)) xcd_barrier(bar); } while (0)
    if (IN(0)) phase_a(F);  SEAM(0);
    if (IN(1)) phase_b(F);  SEAM(1);
    if (IN(2)) phase_c(F);  SEAM(2);
    if (IN(3)) phase_d(F);  SEAM(3);
    if (IN(4)) phase_e(F);  SEAM(4);
    if (IN(5)) phase_f(F);  SEAM(5);
    if (IN(6)) phase_g(F);  SEAM(6);
    if (IN(7)) phase_h(F);  SEAM(7);
    if (IN(8)) phase_i(F);  SEAM(8);
    if (IN(9)) phase_j(F);  SEAM(9);
    if (IN(10)) phase_k(F); SEAM(10);
    if (IN(11)) phase_l(F);
#undef IN
#undef SEAM
}

extern "C" void kernel_launch(void* const* d_in, const int* in_sizes, int n_in, void* d_out, int out_size, void* d_ws, size_t ws_size, hipStream_t stream) {
    static int grid = 0;
    if (grid == 0) {
        if (n_in != 22 || out_size != NLAT * D || ws_size < WS_END) { fprintf(stderr, "kernel_launch: unexpected shapes (n_in %d, out %d, ws %zu)\n", n_in, out_size, ws_size); grid = -1; return; }
        int dev = 0, cus = 0, per_cu = 0;
        hipGetDevice(&dev); hipDeviceGetAttribute(&cus, hipDeviceAttributeMultiprocessorCount, dev);
        if (hipFuncSetAttribute((const void*)mk_fwd, hipFuncAttributeMaxDynamicSharedMemorySize, LDS_BYTES) != hipSuccess) { fprintf(stderr, "kernel_launch: hipFuncSetAttribute failed\n"); grid = -1; return; }
        if (hipOccupancyMaxActiveBlocksPerMultiprocessor(&per_cu, (const void*)mk_fwd, 512, LDS_BYTES) != hipSuccess || per_cu < 1) fprintf(stderr, "kernel_launch: occupancy query says %d\n", per_cu);
        (void)hipGetLastError();
        grid = cus;
        if (grid != 256) fprintf(stderr, "kernel_launch: %d CUs (built for 256)\n", grid);
    }
    if (grid < 0) return;
    hipMemsetAsync((char*)d_ws + WS_CTL, 0, CTL_BYTES, stream);
    Params p{};
    for (int i = 0; i < 22; ++i) p.in[i] = (const float*)d_in[i];
    p.out = (float*)d_out; p.ws = (unsigned char*)d_ws;
#if MK_N_LAUNCHES == 1
    p.ph_lo = 0; p.ph_hi = NPH;
    void* args[] = {&p};
    hipError_t e = hipLaunchCooperativeKernel((const void*)mk_fwd, dim3(grid), dim3(512), args, LDS_BYTES, stream);
    if (e != hipSuccess) fprintf(stderr, "kernel_launch: cooperative launch failed: %s\n", hipGetErrorString(e));
#else
    for (int ph = 0; ph < NPH; ++ph) { p.ph_lo = ph; p.ph_hi = ph + 1; hipLaunchKernelGGL(mk_fwd, dim3(grid), dim3(512), LDS_BYTES, stream, p); }
#endif
}
```

```cpp
#include <hip/hip_runtime.h>
#include <cstdio>
#include <cstdint>

#ifndef MK_N_LAUNCHES
#define MK_N_LAUNCHES 1
#endif
#ifndef NAIVE_GEMM
#define NAIVE_GEMM 0
#endif
#ifndef NAIVE_MM
#define NAIVE_MM 0
#endif

#define LAS __attribute__((address_space(3)))
#define GAS __attribute__((address_space(1)))
typedef unsigned short bf16;
typedef float f32x2 __attribute__((ext_vector_type(2)));
typedef float f32x4 __attribute__((ext_vector_type(4)));
typedef float f32x16 __attribute__((ext_vector_type(16)));
typedef short bf16x8 __attribute__((ext_vector_type(8)));
typedef short s16x4 __attribute__((ext_vector_type(4)));
typedef unsigned u32x2 __attribute__((ext_vector_type(2)));
typedef unsigned u32x4 __attribute__((ext_vector_type(4)));
typedef LAS unsigned char* ldsp;
typedef const LAS unsigned char* ldscp;

constexpr int D = 1024, NB = 4, SEQ = 4096, CTXL = 256, NLAT = NB * SEQ, NCTX = NB * CTXL, NROWS = NLAT + NCTX;
constexpr int PROJ_W = 3088, PW = 3072, NH = 4, DH = 128, CH = 128, NCHUNK = SEQ / CH, NE = 16, CAP = 512, DE = 2048;
constexpr int NSCAN = NB * NH * 2, NSTEP = NCHUNK + 2;
constexpr float EPS = 1e-6f;
constexpr int NPH = 12;

constexpr size_t MiB = 1u << 20;
constexpr size_t WS_CTL = 0, CTL_BYTES = 64 * 1024;
constexpr size_t WS_MOD = 1 * MiB;
constexpr size_t WS_GATES = 2 * MiB;
constexpr size_t WS_AFFT = 4 * MiB;
constexpr size_t WS_SLOT = 5 * MiB;
constexpr size_t WS_GATEV = 6 * MiB;
constexpr size_t WS_SC = 7 * MiB;
constexpr size_t WS_MST = WS_SC + 64 * 1024, WS_NST = WS_SC + 128 * 1024;
constexpr size_t WS_WINT = 8 * MiB;
constexpr size_t WS_WOUTT = 14 * MiB;
constexpr size_t WS_WSB = 16 * MiB;
constexpr size_t WS_DN = 17 * MiB;
constexpr size_t WS_WE1 = 32 * MiB;
constexpr size_t WS_WE2 = 160 * MiB;
constexpr size_t WS_H = 224 * MiB;
constexpr size_t WS_P = 258 * MiB;
constexpr size_t WS_PCTX = 354 * MiB;
constexpr size_t WS_DC = 356 * MiB;
constexpr size_t WS_CST = 426 * MiB;
constexpr size_t WS_YMIX = 460 * MiB;
constexpr size_t WS_XE = 256 * MiB;
constexpr size_t WS_HID = 320 * MiB;
constexpr size_t WS_YE = 448 * MiB;
constexpr size_t WS_END = 512 * MiB;

constexpr int RING_BYTES = 131072, TAB_OFF = 131072, TAB_BYTES = 12288, MISC_OFF = TAB_OFF + TAB_BYTES, LDS_BYTES = 147456;
constexpr int TILE_BYTES = 32768;

__device__ __forceinline__ unsigned f2bf(float f) { unsigned u = __builtin_bit_cast(unsigned, f); return (u + 0x7fffu + ((u >> 16) & 1u)) >> 16; }
__device__ __forceinline__ unsigned pk2(float lo, float hi) { return f2bf(lo) | (f2bf(hi) << 16); }
__device__ __forceinline__ float bf2f(unsigned b) { return __builtin_bit_cast(float, b << 16); }
__device__ __forceinline__ float bflo(unsigned w) { return __builtin_bit_cast(float, w << 16); }
__device__ __forceinline__ float bfhi(unsigned w) { return __builtin_bit_cast(float, w & 0xffff0000u); }
__device__ __forceinline__ float fexp(float x) { return __builtin_amdgcn_exp2f(x * 1.4426950408889634f); }
__device__ __forceinline__ float frcp(float x) { return __builtin_amdgcn_rcpf(x); }
__device__ __forceinline__ float silu_f(float x) { return x * frcp(1.f + __builtin_amdgcn_exp2f(x * -1.4426950408889634f)); }
__device__ __forceinline__ float sigmoid_f(float x) { return frcp(1.f + __builtin_amdgcn_exp2f(x * -1.4426950408889634f)); }
__device__ __forceinline__ float gelu_f(float x) { const float t = x * (1.f + 0.044715f * x * x); return x * frcp(1.f + __builtin_amdgcn_exp2f(t * -2.3022082007f)); }
__device__ __forceinline__ float logsig_f(float x) { return fminf(x, 0.f) - log1pf(fexp(-fabsf(x))); }
__device__ __forceinline__ float wave_sum(float v) {
#pragma unroll
    for (int o = 1; o < 64; o <<= 1) v += __shfl_xor(v, o);
    return v;
}
#define LDS_WAIT() asm volatile("s_waitcnt lgkmcnt(0)" ::: "memory")
#define VM_WAIT() asm volatile("s_waitcnt vmcnt(0)" ::: "memory")

#define XB_TMO      128
#define XB_XCNT(j)  (256  + 64 * (j))
#define XB_XSUB(j)  (1280 + 64 * (j))
#define XB_XGEN(j)  (2304 + 64 * (j))
#define XB_TOP      3328
#define XB_TOPGEN   3392
#define XCD_BAR_WORDS 3456
#define XB_SPIN_CAP (1u << 22)
__device__ __forceinline__ unsigned xb_ld(unsigned* p)              { return __hip_atomic_load(p, __ATOMIC_RELAXED, __HIP_MEMORY_SCOPE_AGENT); }
__device__ __forceinline__ unsigned xb_add(unsigned* p, unsigned v) { return __hip_atomic_fetch_add(p, v, __ATOMIC_RELAXED, __HIP_MEMORY_SCOPE_AGENT); }
__device__ __forceinline__ unsigned xb_xcc_id() { return (unsigned)__builtin_amdgcn_s_getreg((3 << 11) | 20) & 0xFu; }
#define XB_SPIN(cond, bar) do { unsigned _sp = 0; while (cond) { __builtin_amdgcn_s_sleep(1); \
    if ((++_sp & 255u) == 0u) { if (xb_ld(&(bar)[XB_TMO])) break; if (_sp > XB_SPIN_CAP) { atomicAdd(&(bar)[XB_TMO], 1u); break; } } } } while (0)
struct XcdBarrier { unsigned* bar; unsigned x; volatile LAS unsigned* st; };
__device__ __forceinline__ XcdBarrier xcd_barrier_post(unsigned* bar, volatile LAS unsigned* st) {
    XcdBarrier b; b.bar = bar; b.x = xb_xcc_id(); b.st = st;
    if (threadIdx.x == 0) (void)xb_add(&bar[XB_XCNT(b.x)], 1u);
    return b;
}
__device__ __forceinline__ void xcd_barrier_complete(unsigned* bar, unsigned x, unsigned& nloc, unsigned& nx) {
    const unsigned G = gridDim.x * gridDim.y * gridDim.z;
    unsigned sum, cnt, mine, sp = 0u;
    for (;;) {
        sum = 0u; cnt = 0u; mine = 0u;
#pragma unroll
        for (unsigned j = 0; j < 16; ++j) { const unsigned c = xb_ld(&bar[XB_XCNT(j)]); sum += c; cnt += (c > 0u) ? 1u : 0u; mine = (j == x) ? c : mine; }
        if (sum == G) break;
        __builtin_amdgcn_s_sleep(1);
        if ((++sp & 255u) == 0u) { if (xb_ld(&bar[XB_TMO])) break; if (sp > XB_SPIN_CAP) { atomicAdd(&bar[XB_TMO], 1u); break; } }
    }
    nloc = mine > 0u ? mine : 1u; nx = cnt > 0u ? cnt : 1u;
}
__device__ __forceinline__ void xcd_barrier(const XcdBarrier& b) {
    asm volatile("s_waitcnt vmcnt(0)" ::: "memory");
    __syncthreads();
    if (threadIdx.x == 0) {
        unsigned* bar = b.bar;
        __builtin_amdgcn_s_waitcnt(0);
        unsigned nloc = b.st[0], nx = b.st[1];
        if (nloc == 0u) { xcd_barrier_complete(bar, b.x, nloc, nx); b.st[0] = nloc; b.st[1] = nx; }
        const unsigned old = xb_add(&bar[XB_XSUB(b.x)], 1u);
        const unsigned gen = old / nloc;
        if (old + 1u == (gen + 1u) * nloc) {
            __builtin_amdgcn_fence(__ATOMIC_RELEASE, "agent");
            asm volatile("s_waitcnt vmcnt(0)" ::: "memory");
            const unsigned og = xb_add(&bar[XB_TOP], 1u);
            const unsigned tg = og / nx;
            if (og + 1u == (tg + 1u) * nx) xb_add(&bar[XB_TOPGEN], 1u);
            else XB_SPIN(xb_ld(&bar[XB_TOPGEN]) == tg, bar);
            __builtin_amdgcn_fence(__ATOMIC_ACQUIRE, "agent");
            xb_add(&bar[XB_XGEN(b.x)], 1u);
            asm volatile("s_waitcnt vmcnt(0)" ::: "memory");
        } else {
            XB_SPIN(xb_ld(&bar[XB_XGEN(b.x)]) == gen, bar);
            __builtin_amdgcn_fence(__ATOMIC_ACQUIRE, "agent");
            asm volatile("s_waitcnt vmcnt(0)" ::: "memory");
        }
    }
    __syncthreads();
}

struct Params { const float* in[22]; float* out; unsigned char* ws; int ph_lo, ph_hi; };
enum { I_X = 0, I_C, I_CTX, I_CCTX, I_WMOD, I_BMOD, I_GMIX, I_WIN, I_CONVQ, I_CONVK, I_BI, I_BF, I_GWS, I_GBS, I_MNG, I_WOUT, I_GFFN, I_WR, I_WG, I_WU, I_WD, I_GFIN };

struct Frame {
    ldsp lds; int tid, lane, wave, vcu, G;
    const Params* p;
};

__device__ __forceinline__ unsigned toff(unsigned row, unsigned ch) { return 256u * row + 16u * (ch ^ (((row & 3u) << 2) | ((row >> 2) & 3u))); }
__device__ __forceinline__ float tile_el(ldscp T, int r, int c) { return bf2f(*(const LAS unsigned short*)(T + toff(r, c >> 3) + 2 * (c & 7))); }
__device__ __forceinline__ bf16x8 frag_row(ldscp T, int r0, int s, int lane) { return *(const LAS bf16x8*)(T + toff(r0 + (lane & 31), 2 * s + (lane >> 5))); }
__device__ __forceinline__ bf16x8 frag_tr(ldscp T, int c, int ks, int lane) {
    const unsigned h = lane >> 5, blk = (lane >> 4) & 1, q = (lane & 15) >> 2, p = lane & 3;
    const unsigned a0 = toff(16 * ks + 8 * h + q, 4 * c + 2 * blk + (p >> 1)) + 8 * (p & 1);
    const unsigned a1 = toff(16 * ks + 8 * h + 4 + q, 4 * c + 2 * blk + (p >> 1)) + 8 * (p & 1);
    const s16x4 lo = __builtin_bit_cast(s16x4, __builtin_amdgcn_ds_read_tr16_b64_v4i16((LAS s16x4*)(T + a0)));
    const s16x4 hi = __builtin_bit_cast(s16x4, __builtin_amdgcn_ds_read_tr16_b64_v4i16((LAS s16x4*)(T + a1)));
    return (bf16x8){lo[0], lo[1], lo[2], lo[3], hi[0], hi[1], hi[2], hi[3]};
}
enum { EXT_NONE = 0, EXT_ONES_B = 1, EXT_VEC_B = 2, EXT_ONES_A = 3 };
template <bool TRA, bool TRB, int EXT>
__device__ __forceinline__ void mm128x(f32x16 (&acc)[2], ldscp TA, ldscp TB, int wave, int lane, f32x16& e0, f32x16& e1, ldscp vec) {
    const int rb = wave >> 1, cb0 = 2 * (wave & 1);
    const unsigned h = lane >> 5, blk = (lane >> 4) & 1, q4 = (lane & 15) >> 2, p4 = lane & 3;
    const unsigned trb0 = toff(8 * h + q4, 2 * blk + (p4 >> 1)) + 8 * (p4 & 1), trb1 = toff(8 * h + 4 + q4, 2 * blk + (p4 >> 1)) + 8 * (p4 & 1);
    const unsigned rwa = toff(32 * rb + (lane & 31), h), rwb = toff(32 * cb0 + (lane & 31), h);
    const bf16x8 ones = {(short)0x3F80, (short)0x3F80, (short)0x3F80, (short)0x3F80, (short)0x3F80, (short)0x3F80, (short)0x3F80, (short)0x3F80};
#define MM_TR(T, c, ks) ({ const s16x4 lo_ = __builtin_bit_cast(s16x4, __builtin_amdgcn_ds_read_tr16_b64_v4i16((LAS s16x4*)((T) + ((trb0 ^ ((unsigned)(c) << 6)) + 4096u * (ks))))); \
                           const s16x4 hi_ = __builtin_bit_cast(s16x4, __builtin_amdgcn_ds_read_tr16_b64_v4i16((LAS s16x4*)((T) + ((trb1 ^ ((unsigned)(c) << 6)) + 4096u * (ks))))); \
                           (bf16x8){lo_[0], lo_[1], lo_[2], lo_[3], hi_[0], hi_[1], hi_[2], hi_[3]}; })
#define MM_ROW(T, base, s, extra) (*(const LAS bf16x8*)((T) + (((base) ^ ((unsigned)(s) << 5)) + (extra))))
#define MM_LDA(s) (TRA ? MM_TR(TA, rb, s) : MM_ROW(TA, rwa, s, 0u))
#define MM_LDB(s, cbi) (TRB ? MM_TR(TB, cb0 + (cbi), s) : MM_ROW(TB, rwb, s, 8192u * (cbi)))
    bf16x8 a = MM_LDA(0), b0 = MM_LDB(0, 0), b1 = MM_LDB(0, 1);
#pragma unroll
    for (int s = 0; s < 8; ++s) {
        bf16x8 an = a, b0n = b0, b1n = b1;
        if (s < 7) { an = MM_LDA(s + 1); b0n = MM_LDB(s + 1, 0); b1n = MM_LDB(s + 1, 1); }
        acc[0] = __builtin_amdgcn_mfma_f32_32x32x16_bf16(a, b0, acc[0], 0, 0, 0);
        acc[1] = __builtin_amdgcn_mfma_f32_32x32x16_bf16(a, b1, acc[1], 0, 0, 0);
        if (EXT == EXT_ONES_B) e0 = __builtin_amdgcn_mfma_f32_32x32x16_bf16(a, ones, e0, 0, 0, 0);
        if (EXT == EXT_VEC_B) { const bf16x8 nv = *(const LAS bf16x8*)(vec + 32 * s + 16 * h); e0 = __builtin_amdgcn_mfma_f32_32x32x16_bf16(a, nv, e0, 0, 0, 0); }
        if (EXT == EXT_ONES_A) { e0 = __builtin_amdgcn_mfma_f32_32x32x16_bf16(ones, b0, e0, 0, 0, 0); e1 = __builtin_amdgcn_mfma_f32_32x32x16_bf16(ones, b1, e1, 0, 0, 0); }
        asm volatile("" ::: "memory");
        a = an; b0 = b0n; b1 = b1n;
    }
#undef MM_TR
#undef MM_ROW
#undef MM_LDA
#undef MM_LDB
}
template <bool TRA, bool TRB>
__device__ __forceinline__ void mm128(f32x16 (&acc)[2], ldscp TA, ldscp TB, int wave, int lane) { f32x16 d0, d1; mm128x<TRA, TRB, EXT_NONE>(acc, TA, TB, wave, lane, d0, d1, TA); }
#define ACC_ROW(rb, r, lane) (32 * (rb) + ((r) & 3) + 8 * ((r) >> 2) + 4 * ((lane) >> 5))

__device__ __forceinline__ void load_tile(ldsp T, const bf16* g, size_t pitch, int tid) {
#pragma unroll
    for (int i = 0; i < 4; ++i) { const int q = tid + 512 * i, row = q >> 4, ch = q & 15;
        const u32x4 v = *(const u32x4*)(g + (size_t)row * pitch + ch * 8);
        *(LAS u32x4*)(T + toff(row, ch)) = v; }
}
__device__ __forceinline__ void store_tile(ldscp T, bf16* g, size_t pitch, int tid) {
#pragma unroll
    for (int i = 0; i < 4; ++i) { const int q = tid + 512 * i, row = q >> 4, ch = q & 15;
        *(u32x4*)(g + (size_t)row * pitch + ch * 8) = *(const LAS u32x4*)(T + toff(row, ch)); }
}

namespace pg8 {
constexpr int BM = 256, BK = 64, HALF = 128, HTB = HALF * BK * 2, NXCD = 8, WGM = 8;
__device__ __forceinline__ int lds_byte(int r, int c) { const int st = (r >> 4) * 2 + (c >> 5), rr = r & 15, cc = c & 31, ob = rr * 64 + cc * 2; return st * 1024 + (ob ^ (((ob >> 9) & 1) << 5)); }
__device__ __forceinline__ void stage_rc(int b, int& R, int& C) { const int st = b / 1024, sb = b % 1024, swz = sb ^ (((sb >> 9) & 1) << 5); R = (st >> 1) * 16 + swz / 64; C = (st & 1) * 32 + (swz % 64) / 2; }
__device__ __forceinline__ int perm32(int rho) { const int n = rho >> 4, i = rho & 15; return 8 * (i >> 2) + 4 * n + (i & 3); }
struct Unit { int pm, pn; };
struct Gemm { const bf16* A; const bf16* Bt; int K; };
__device__ __forceinline__ int xcd_remap(int wgid, int nwg) { const int q = nwg / NXCD, r = nwg % NXCD, xcd = wgid % NXCD, off = wgid / NXCD; return (xcd < r ? xcd * (q + 1) : r * (q + 1) + (xcd - r) * q) + off; }
struct DenseOrder {
    int nM, nN, nwg, G, c;
    __device__ void init(int nM_, int nN_, int G_, int c_) { nM = nM_; nN = nN_; nwg = nM * nN; G = G_; c = c_; }
    __device__ bool map(int L, Unit& u) const {
        if (L >= nwg) return false;
        const int wgid = xcd_remap(L, nwg);
        const int nig = WGM * nN, gid = wgid / nig, fm = gid * WGM, gsz = (nM - fm) < WGM ? (nM - fm) : WGM;
        u.pm = fm + ((wgid % nig) % gsz); u.pn = (wgid % nig) / gsz; return true;
    }
    __device__ bool next(int i, Unit& u) const { return map(i * G + c, u); }
};
struct InProjOrder {
    DenseOrder d;
    __device__ void init(int G_, int c_) { d.init(64, 12, G_, c_); }
    __device__ bool next(int i, Unit& u) const {
        const int L = i * d.G + d.c;
        if (L < 768) return d.map(L, u);
        if (L < 784) { const int q = L - 768; u.pm = 64 + (q & 3); u.pn = 8 + (q >> 2); return true; }
        return false;
    }
};
struct GroupedOrder {
    int nMe, nNe, nwg, G, c;
    __device__ void init(int nMe_, int nNe_, int G_, int c_) { nMe = nMe_; nNe = nNe_; nwg = NE * nMe * nNe; G = G_; c = c_; }
    __device__ bool next(int i, Unit& u) const {
        const int L = i * G + c; if (L >= nwg) return false;
        const int wgid = xcd_remap(L, nwg), per = nMe * nNe, e = wgid / per, w = wgid % per;
        u.pm = e * nMe + (w % nMe); u.pn = e * nNe + (w / nMe); return true;
    }
};
__device__ __forceinline__ unsigned cvt_pk_bf16(float lo, float hi) { unsigned r; asm volatile("v_cvt_pk_bf16_f32 %0, %1, %2" : "=v"(r) : "v"(lo), "v"(hi)); return r; }

#if NAIVE_GEMM
template <class Epi, class Sched>
__device__ __forceinline__ void gemm_phase(ldsp lds, const Gemm g, const Sched& S, const Epi& E) {
    const int tid = threadIdx.x, wid = tid >> 6, lane = tid & 63, wr = wid >> 2, wc = wid & 3, fr = lane & 15, fq = lane >> 4;
    const int K = g.K;
    Unit u;
    for (int ui = 0; S.next(ui, u); ++ui) {
        f32x4 acc[2][2][4][2];
#pragma unroll
        for (int ai = 0; ai < 2; ++ai)
#pragma unroll
            for (int m = 0; m < 4; ++m) {
                const bf16* arow = g.A + (size_t)(u.pm * 256 + 128 * ai + 64 * wr + 16 * m + fr) * K;
#pragma unroll
                for (int bj = 0; bj < 2; ++bj)
#pragma unroll
                    for (int n = 0; n < 2; ++n) {
                        f32x4 a4 = {0.f, 0.f, 0.f, 0.f};
#pragma unroll
                        for (int j = 0; j < 4; ++j) {
                            const int col = u.pn * 256 + 128 * bj + 32 * wc + (Epi::PERM ? (8 * fq + 4 * n) : (16 * n + 4 * fq)) + j;
                            const bf16* brow = g.Bt + (size_t)col * K;
                            float s = 0.f;
                            for (int k = 0; k < K; k += 8) {
                                const u32x4 av = *(const u32x4*)(arow + k), bv = *(const u32x4*)(brow + k);
                                s += bflo(av.x) * bflo(bv.x) + bfhi(av.x) * bfhi(bv.x) + bflo(av.y) * bflo(bv.y) + bfhi(av.y) * bfhi(bv.y)
                                   + bflo(av.z) * bflo(bv.z) + bfhi(av.z) * bfhi(bv.z) + bflo(av.w) * bflo(bv.w) + bfhi(av.w) * bfhi(bv.w);
                            }
                            a4[j] = s;
                        }
                        acc[ai][bj][m][n] = a4;
                    }
            }
        E(acc, u, wr, wc, fr, fq);
    }
}
#else
template <class Epi, class Sched>
__device__ __forceinline__ void gemm_phase(ldsp lds, const Gemm g, const Sched& S, const Epi& E) {
    const int tid = threadIdx.x, wid = __builtin_amdgcn_readfirstlane(tid >> 6), lane = tid & 63, wr = wid >> 2, wc = wid & 3, fr = lane & 15, fq = lane >> 4;
    const int K = g.K, nt = K / BK;
    unsigned voffA[2], voffB[2];
#pragma unroll
    for (int i = 0; i < 2; ++i) { int R, C; stage_rc(tid * 16 + i * 8192, R, C); const int Rb = Epi::PERM ? ((R & ~31) + perm32(R & 31)) : R;
        voffA[i] = (unsigned)(R * K + C) * 2u; voffB[i] = (unsigned)(Rb * K + C) * 2u; }
    const size_t kstep = (size_t)(BK * 2);
    const size_t hstep = (size_t)HALF * K * 2;
    const size_t tstep = 2 * hstep;
    const unsigned ldsw = (unsigned)wid * 1024u;
    const int aoff = lds_byte(wr * 64 + fr, fq * 8), boff = lds_byte(wc * 32 + fr, fq * 8);
#define PG8_SA(b, h) (((b) * 2 + (h)) * HTB)
#define PG8_SB(b, h) ((4 + (b) * 2 + (h)) * HTB)
#define PG8_STAGE(bufoff, gbase, voff) do { _Pragma("unroll") for (int _i = 0; _i < 2; ++_i) \
        __builtin_amdgcn_global_load_lds((const unsigned*)((const char*)(gbase) + (voff)[_i]), (LAS unsigned*)(lds + (bufoff) + ldsw + _i * 8192), 16, 0, 0); } while (0)
#define PG8_LDA(dst, b, h) do { _Pragma("unroll") for (int m = 0; m < 4; ++m) _Pragma("unroll") for (int k = 0; k < 2; ++k) dst[m][k] = *(const LAS bf16x8*)(lds + PG8_SA(b, h) + aoff + m * 2048 + k * 1024); } while (0)
#define PG8_LDB(dst, b, h) do { _Pragma("unroll") for (int n = 0; n < 2; ++n) _Pragma("unroll") for (int k = 0; k < 2; ++k) dst[n][k] = *(const LAS bf16x8*)(lds + PG8_SB(b, h) + boff + n * 2048 + k * 1024); } while (0)
#define PG8_MMA(ai, bj, At, Bt) do { __builtin_amdgcn_s_setprio(1); _Pragma("unroll") for (int m = 0; m < 4; ++m) _Pragma("unroll") for (int n = 0; n < 2; ++n) _Pragma("unroll") for (int k = 0; k < 2; ++k) \
        acc[ai][bj][m][n] = __builtin_amdgcn_mfma_f32_16x16x32_bf16(Bt[n][k], At[m][k], acc[ai][bj][m][n], 0, 0, 0); __builtin_amdgcn_s_setprio(0); } while (0)
#define PG8_WAIT_V(n) asm volatile("s_waitcnt vmcnt(" #n ")" ::: "memory")
#define PG8_WAIT_L(n) asm volatile("s_waitcnt lgkmcnt(" #n ")" ::: "memory")
#define PG8_BAR __builtin_amdgcn_s_barrier()
#define PG8_SCHED __builtin_amdgcn_sched_barrier(0)
    Unit cur, nxt; int ui = 0;
    if (!S.next(0, cur)) return;
    f32x4 acc[2][2][4][2];
#pragma unroll
    for (int a = 0; a < 2; ++a)
#pragma unroll
        for (int b = 0; b < 2; ++b)
#pragma unroll
            for (int m = 0; m < 4; ++m)
#pragma unroll
                for (int n = 0; n < 2; ++n) acc[a][b][m][n] = (f32x4){0.f, 0.f, 0.f, 0.f};
    bf16x8 At[4][2], B0[2][2], B1[2][2];
    const char* cA = (const char*)g.A + (size_t)cur.pm * tstep; const char* cB = (const char*)g.Bt + (size_t)cur.pn * tstep;
    PG8_STAGE(PG8_SB(0, 0), cB, voffB); PG8_STAGE(PG8_SB(0, 1), cB + hstep, voffB); PG8_STAGE(PG8_SA(0, 0), cA, voffA); PG8_STAGE(PG8_SA(0, 1), cA + hstep, voffA);
    if (wr == 1) PG8_BAR;
    PG8_WAIT_V(2); PG8_BAR;
    PG8_STAGE(PG8_SB(1, 0), cB + kstep, voffB); PG8_STAGE(PG8_SA(1, 0), cA + kstep, voffA); PG8_STAGE(PG8_SB(1, 1), cB + hstep + kstep, voffB);
    PG8_WAIT_V(6); PG8_BAR;
    for (;;) {
        const bool has_next = S.next(ui + 1, nxt);
        const char* nA = has_next ? (const char*)g.A + (size_t)nxt.pm * tstep : cA; const char* nB = has_next ? (const char*)g.Bt + (size_t)nxt.pn * tstep : cB;
        for (int t = 0; t < nt; t += 2) {
            const bool last = (t == nt - 2);
            const char* a1 = cA + (size_t)(t + 1) * kstep;
            const char* a2 = last ? nA : cA + (size_t)(t + 2) * kstep; const char* b2 = last ? nB : cB + (size_t)(t + 2) * kstep;
            const char* a3 = a2 + kstep; const char* b3 = b2 + kstep;
            PG8_LDB(B0, 0, 0); PG8_LDB(B1, 0, 1); PG8_SCHED; PG8_LDA(At, 0, 0); PG8_STAGE(PG8_SA(1, 1), a1 + hstep, voffA);
            PG8_WAIT_V(8); PG8_WAIT_L(0); PG8_BAR; PG8_MMA(0, 0, At, B0); PG8_MMA(0, 1, At, B1); PG8_BAR; PG8_SCHED;
            PG8_LDA(At, 0, 1); PG8_STAGE(PG8_SB(0, 0), b2, voffB); PG8_STAGE(PG8_SB(0, 1), b2 + hstep, voffB); PG8_STAGE(PG8_SA(0, 0), a2, voffA);
            PG8_WAIT_V(8); PG8_WAIT_L(0); PG8_BAR; PG8_MMA(1, 0, At, B0); PG8_MMA(1, 1, At, B1); PG8_BAR; PG8_SCHED;
            PG8_LDB(B0, 1, 0); PG8_LDB(B1, 1, 1); PG8_SCHED; PG8_LDA(At, 1, 0); PG8_STAGE(PG8_SA(0, 1), a2 + hstep, voffA);
            PG8_WAIT_V(8); PG8_WAIT_L(0); PG8_BAR; PG8_MMA(0, 0, At, B0); PG8_MMA(0, 1, At, B1); PG8_BAR; PG8_SCHED;
            PG8_LDA(At, 1, 1); PG8_STAGE(PG8_SB(1, 0), b3, voffB); PG8_STAGE(PG8_SB(1, 1), b3 + hstep, voffB); PG8_STAGE(PG8_SA(1, 0), a3, voffA);
            PG8_WAIT_V(8); PG8_WAIT_L(0); PG8_BAR; PG8_MMA(1, 0, At, B0); PG8_MMA(1, 1, At, B1); PG8_BAR; PG8_SCHED;
        }
        if (wr == 0) PG8_BAR;
        E(acc, cur, wr, wc, fr, fq);
        if (!has_next) break;
#pragma unroll
        for (int a = 0; a < 2; ++a)
#pragma unroll
            for (int b = 0; b < 2; ++b)
#pragma unroll
                for (int m = 0; m < 4; ++m)
#pragma unroll
                    for (int n = 0; n < 2; ++n) acc[a][b][m][n] = (f32x4){0.f, 0.f, 0.f, 0.f};
        cur = nxt; cA = nA; cB = nB; ++ui;
        if (wr == 1) PG8_BAR;
    }
    PG8_WAIT_V(0);
    PG8_BAR;
#undef PG8_SA
#undef PG8_SB
#undef PG8_STAGE
#undef PG8_LDA
#undef PG8_LDB
#undef PG8_MMA
#undef PG8_WAIT_V
#undef PG8_WAIT_L
#undef PG8_BAR
#undef PG8_SCHED
}
#endif

struct EpiInProj {
    static constexpr bool PERM = true;
    bf16* P; bf16* PC;
    __device__ __forceinline__ void operator()(const f32x4 (&acc)[2][2][4][2], const Unit& u, int wr, int wc, int fr, int fq) const {
        const bool isctx = u.pm >= 64;
        const int row0 = (isctx ? (u.pm - 64) : u.pm) * BM + wr * 64 + fr;
        const int col0 = (isctx ? (u.pn - 8) : u.pn) * BM + wc * 32 + 8 * fq;
        bf16* base = isctx ? PC : P; const int ldc = isctx ? 1024 : PW;
#pragma unroll
        for (int ai = 0; ai < 2; ++ai)
#pragma unroll
            for (int m = 0; m < 4; ++m) { bf16* rowp = base + (size_t)(row0 + ai * HALF + m * 16) * ldc + col0;
#pragma unroll
                for (int bj = 0; bj < 2; ++bj) { const f32x4 v0 = acc[ai][bj][m][0], v1 = acc[ai][bj][m][1];
                    u32x4 w; w.x = cvt_pk_bf16(v0[0], v0[1]); w.y = cvt_pk_bf16(v0[2], v0[3]); w.z = cvt_pk_bf16(v1[0], v1[1]); w.w = cvt_pk_bf16(v1[2], v1[3]);
                    *(u32x4*)(rowp + bj * HALF) = w; } }
    }
};
struct EpiOut {
    static constexpr bool PERM = false;
    const float* x; float* out; const float* mod;
    __device__ __forceinline__ void operator()(const f32x4 (&acc)[2][2][4][2], const Unit& u, int wr, int wc, int fr, int fq) const {
        const int row0 = u.pm * BM + wr * 64 + fr, col0 = u.pn * BM + wc * 32 + 4 * fq;
        const int b = (u.pm * BM) / SEQ;
        f32x4 gv[2][2];
#pragma unroll
        for (int bj = 0; bj < 2; ++bj)
#pragma unroll
            for (int n = 0; n < 2; ++n) gv[bj][n] = *(const f32x4*)(mod + b * 6144 + 2048 + col0 + bj * HALF + n * 16);
#pragma unroll
        for (int ai = 0; ai < 2; ++ai)
#pragma unroll
            for (int m = 0; m < 4; ++m) { const size_t off = (size_t)(row0 + ai * HALF + m * 16) * D + col0;
#pragma unroll
                for (int bj = 0; bj < 2; ++bj)
#pragma unroll
                    for (int n = 0; n < 2; ++n) { const f32x4 xv = *(const f32x4*)(x + off + bj * HALF + n * 16);
                        *(f32x4*)(out + off + bj * HALF + n * 16) = xv + gv[bj][n] * acc[ai][bj][m][n]; } }
    }
};
struct EpiGU {
    static constexpr bool PERM = true;
    bf16* hid;
    __device__ __forceinline__ void operator()(const f32x4 (&acc)[2][2][4][2], const Unit& u, int wr, int wc, int fr, int fq) const {
        const int row0 = u.pm * BM + wr * 64 + fr, col0 = (u.pn & 15) * 128 + wc * 32 + 8 * fq;
#pragma unroll
        for (int ai = 0; ai < 2; ++ai)
#pragma unroll
            for (int m = 0; m < 4; ++m) { bf16* rowp = hid + (size_t)(row0 + ai * HALF + m * 16) * DE + col0;
                float h[8];
#pragma unroll
                for (int n = 0; n < 2; ++n)
#pragma unroll
                    for (int j = 0; j < 4; ++j) { const float a = acc[ai][0][m][n][j], up = acc[ai][1][m][n][j]; h[4 * n + j] = a * __builtin_amdgcn_rcpf(1.f + __builtin_amdgcn_exp2f(a * -1.4426950408889634f)) * up; }
                u32x4 w; w.x = cvt_pk_bf16(h[0], h[1]); w.y = cvt_pk_bf16(h[2], h[3]); w.z = cvt_pk_bf16(h[4], h[5]); w.w = cvt_pk_bf16(h[6], h[7]);
                *(u32x4*)rowp = w; }
    }
};
struct EpiDown {
    static constexpr bool PERM = true;
    bf16* ye; const float* gatev;
    __device__ __forceinline__ void operator()(const f32x4 (&acc)[2][2][4][2], const Unit& u, int wr, int wc, int fr, int fq) const {
        const int row0 = u.pm * BM + wr * 64 + fr, col0 = (u.pn & 3) * BM + wc * 32 + 8 * fq;
#pragma unroll
        for (int ai = 0; ai < 2; ++ai)
#pragma unroll
            for (int m = 0; m < 4; ++m) { const int row = row0 + ai * HALF + m * 16; const float gt = gatev[row]; bf16* rowp = ye + (size_t)row * D + col0;
#pragma unroll
                for (int bj = 0; bj < 2; ++bj) { const f32x4 v0 = acc[ai][bj][m][0] * gt, v1 = acc[ai][bj][m][1] * gt;
                    u32x4 w; w.x = cvt_pk_bf16(v0[0], v0[1]); w.y = cvt_pk_bf16(v0[2], v0[3]); w.z = cvt_pk_bf16(v1[0], v1[1]); w.w = cvt_pk_bf16(v1[2], v1[3]);
                    *(u32x4*)(rowp + bj * HALF) = w; } }
    }
};
}

#define WSP(T, off) ((T*)(F.p->ws + (off)))
#define INP(i) (F.p->in[i])

__device__ __forceinline__ void transpose_item(const float* W, int K, int N, bf16* WT, int drow0, LAS float* scr, int kb, int nb, int lane) {
    const int k0 = 64 * kb, n0 = 32 * nb;
#pragma unroll 8
    for (int i = 0; i < 32; ++i) { const int kk = 2 * i + (lane >> 5); scr[kk * 33 + (lane & 31)] = W[(size_t)(k0 + kk) * N + n0 + (lane & 31)]; }
    LDS_WAIT(); asm volatile("" ::: "memory");
    const int c = lane & 7;
#pragma unroll
    for (int j = 0; j < 4; ++j) { const int n = (lane >> 3) + 8 * j; const LAS float* s = scr + (8 * c) * 33 + n;
        u32x4 o; o.x = pk2(s[0 * 33], s[1 * 33]); o.y = pk2(s[2 * 33], s[3 * 33]); o.z = pk2(s[4 * 33], s[5 * 33]); o.w = pk2(s[6 * 33], s[7 * 33]);
        *(u32x4*)(WT + (size_t)(drow0 + n) * K + k0 + 8 * c) = o; }
    LDS_WAIT(); asm volatile("" ::: "memory");
}

__device__ __forceinline__ void phase_a(Frame& F) {
    const int tid = F.tid, lane = F.lane, wave = F.wave;
    if (F.vcu < 192) {
        LAS float* sc = (LAS float*)F.lds;
        LAS float* red = (LAS float*)(F.lds + 32768);
        for (int i = tid; i < 5 * 1024; i += 512) { const int b = i >> 10, k = i & 1023; const float v = (b < 4) ? INP(I_C)[b * 1024 + k] : INP(I_CCTX)[k]; sc[i] = silu_f(v); }
        __syncthreads();
        const int n0 = 32 * F.vcu, col = lane & 31, kh = lane >> 5;
        const float* wm = INP(I_WMOD);
        float a0 = 0.f, a1 = 0.f, a2 = 0.f, a3 = 0.f, a4 = 0.f;
#pragma unroll 8
        for (int i = 0; i < 64; ++i) { const int k = wave * 128 + 2 * i + kh; const float w = wm[(size_t)k * 6144 + n0 + col];
            a0 += sc[k] * w; a1 += sc[1024 + k] * w; a2 += sc[2048 + k] * w; a3 += sc[3072 + k] * w; a4 += sc[4096 + k] * w; }
        const int slot = wave * 2 + kh;
        red[(slot * 5 + 0) * 32 + col] = a0; red[(slot * 5 + 1) * 32 + col] = a1; red[(slot * 5 + 2) * 32 + col] = a2; red[(slot * 5 + 3) * 32 + col] = a3; red[(slot * 5 + 4) * 32 + col] = a4;
        __syncthreads();
        if (tid < 160) { const int b = tid >> 5, c2 = tid & 31; float s = 0.f;
#pragma unroll
            for (int q = 0; q < 16; ++q) s += red[(q * 5 + b) * 32 + c2];
            if (b < 4 || n0 < 2048) WSP(float, WS_MOD)[b * 6144 + n0 + c2] = s + INP(I_BMOD)[n0 + c2]; }
        __syncthreads();
    }
    {
        LAS float* scr = (LAS float*)(F.lds + wave * 8704);
        const int gw = F.vcu * 8 + wave, NGW = F.G * 8;
        constexpr int I_IN = 16 * 96, I_OUT = 16 * 32, I_G = 16 * 64 * NE, I_U = I_G, I_D = 32 * 32 * NE;
        constexpr int NITEMS = I_IN + I_OUT + I_G + I_U + I_D;
        for (int it = gw; it < NITEMS; it += NGW) {
            int r = it;
            if (r < I_IN) { transpose_item(INP(I_WIN), 1024, PROJ_W, WSP(bf16, WS_WINT), 32 * (r % 96), scr, r / 96, r % 96, lane); continue; } r -= I_IN;
            if (r < I_OUT) { transpose_item(INP(I_WOUT), 1024, 1024, WSP(bf16, WS_WOUTT), 32 * (r % 32), scr, r / 32, r % 32, lane); continue; } r -= I_OUT;
            if (r < I_G + I_U) { const bool up = r >= I_G; if (up) r -= I_G; const int e = r / 1024, q = r % 1024, kb = q / 64, nb = q % 64, n0 = 32 * nb;
                const int drow = e * 4096 + 256 * (n0 >> 7) + (n0 & 127) + (up ? 128 : 0);
                transpose_item(INP(up ? I_WU : I_WG) + (size_t)e * 1024 * 2048, 1024, 2048, WSP(bf16, WS_WE1), drow, scr, kb, nb, lane); continue; } r -= I_G + I_U;
            { const int e = r / 1024, q = r % 1024, kb = q / 32, nb = q % 32;
                transpose_item(INP(I_WD) + (size_t)e * 2048 * 1024, 2048, 1024, WSP(bf16, WS_WE2), e * 1024 + 32 * nb, scr, kb, nb, lane); }
        }
        for (int i = F.vcu * 512 + tid; i < 4 * 128 * 128 / 2; i += F.G * 512) { const f32x2 v = *(const f32x2*)(INP(I_GWS) + 2 * i); WSP(unsigned, WS_WSB)[i] = pk2(v.x, v.y); }
    }
}

__device__ __forceinline__ void stage_w16(ldsp L, const float* W, int ldw, int tid) {
#pragma unroll
    for (int i = 0; i < 8; ++i) { const int q = tid + 512 * i, k = q >> 2, c = q & 3, sg = (k & 3) * 256 + (k >> 2);
        *(LAS f32x4*)(L + sg * 64 + 16 * (c ^ ((sg >> 2) & 3))) = *(const f32x4*)(W + (size_t)k * ldw + 4 * c); }
}
template <int R>
__device__ __forceinline__ void row16(ldscp L, const float (&hv)[R][16], float (&out)[R], int lane) {
    float acc[R][16];
#pragma unroll
    for (int r = 0; r < R; ++r)
#pragma unroll
        for (int j = 0; j < 16; ++j) acc[r][j] = 0.f;
    const unsigned sw = (lane >> 2) & 3;
    ldscp base = L + lane * 64;
#pragma unroll
    for (int j = 0; j < 4; ++j)
#pragma unroll
        for (int i = 0; i < 4; ++i) {
#pragma unroll
            for (int c = 0; c < 4; ++c) { const f32x4 w = *(const LAS f32x4*)(base + (i * 256 + 64 * j) * 64 + 16 * (c ^ sw));
#pragma unroll
                for (int r = 0; r < R; ++r) { const float x = hv[r][4 * j + i]; acc[r][4 * c + 0] += x * w[0]; acc[r][4 * c + 1] += x * w[1]; acc[r][4 * c + 2] += x * w[2]; acc[r][4 * c + 3] += x * w[3]; } }
            asm volatile("" ::: "memory"); }
    const bool u5 = lane & 32, u4 = lane & 16, u3 = lane & 8, u2 = lane & 4;
#pragma unroll
    for (int r = 0; r < R; ++r) {
        float v8[8], v4[4], v2[2];
#pragma unroll
        for (int j = 0; j < 8; ++j) { const float keep = u5 ? acc[r][j + 8] : acc[r][j], send = u5 ? acc[r][j] : acc[r][j + 8]; v8[j] = keep + __shfl_xor(send, 32); }
#pragma unroll
        for (int j = 0; j < 4; ++j) { const float keep = u4 ? v8[j + 4] : v8[j], send = u4 ? v8[j] : v8[j + 4]; v4[j] = keep + __shfl_xor(send, 16); }
#pragma unroll
        for (int j = 0; j < 2; ++j) { const float keep = u3 ? v4[j + 2] : v4[j], send = u3 ? v4[j] : v4[j + 2]; v2[j] = keep + __shfl_xor(send, 8); }
        float v1; { const float keep = u2 ? v2[1] : v2[0], send = u2 ? v2[0] : v2[1]; v1 = keep + __shfl_xor(send, 4); }
        v1 += __shfl_xor(v1, 2); v1 += __shfl_xor(v1, 1);
        out[r] = v1;
    }
}
#define IDX16(lane) ((((lane) >> 5) & 1) * 8 + (((lane) >> 4) & 1) * 4 + (((lane) >> 3) & 1) * 2 + (((lane) >> 2) & 1))

template <int R>
__device__ __forceinline__ void pb_rows(Frame& F, const float* src, int row_dst0, const float* gm, const float* shp, const float* scp) {
    const int lane = F.lane;
    float gs[16], sh[16];
#pragma unroll
    for (int j = 0; j < 4; ++j) { const f32x4 g4 = *(const f32x4*)(gm + 256 * j + 4 * lane), s4 = *(const f32x4*)(scp + 256 * j + 4 * lane), h4 = *(const f32x4*)(shp + 256 * j + 4 * lane);
#pragma unroll
        for (int i = 0; i < 4; ++i) { gs[4 * j + i] = g4[i] * (1.f + s4[i]); sh[4 * j + i] = h4[i]; } }
    float hv[R][16];
#pragma unroll
    for (int r = 0; r < R; ++r)
#pragma unroll
        for (int j = 0; j < 4; ++j) { const f32x4 v = *(const f32x4*)(src + (size_t)r * D + 256 * j + 4 * lane); hv[r][4 * j] = v[0]; hv[r][4 * j + 1] = v[1]; hv[r][4 * j + 2] = v[2]; hv[r][4 * j + 3] = v[3]; }
#pragma unroll
    for (int r = 0; r < R; ++r) {
        float ss = 0.f;
#pragma unroll
        for (int q = 0; q < 16; ++q) ss += hv[r][q] * hv[r][q];
        const float rr = rsqrtf(wave_sum(ss) * (1.f / D) + EPS);
        bf16* hrow = WSP(bf16, WS_H) + (size_t)(row_dst0 + r) * D;
#pragma unroll
        for (int j = 0; j < 4; ++j) {
#pragma unroll
            for (int i = 0; i < 4; ++i) hv[r][4 * j + i] = hv[r][4 * j + i] * rr * gs[4 * j + i] + sh[4 * j + i];
            u32x2 o; o.x = pk2(hv[r][4 * j], hv[r][4 * j + 1]); o.y = pk2(hv[r][4 * j + 2], hv[r][4 * j + 3]);
            *(u32x2*)(hrow + 256 * j + 4 * lane) = o; }
    }
    float outv[R];
    row16<R>(F.lds, hv, outv, lane);
#pragma unroll
    for (int r = 0; r < R; ++r) if ((lane & 3) == 0) WSP(float, WS_GATES)[(size_t)(row_dst0 + r) * 16 + IDX16(lane)] = outv[r];
}
__device__ __forceinline__ void phase_b(Frame& F) {
    stage_w16(F.lds, INP(I_WIN) + PW, PROJ_W, F.tid);
    __syncthreads();
    const int gw = F.vcu * 8 + F.wave;
    const float* mod = WSP(float, WS_MOD);
    { const int row0 = gw * 8, b = row0 / SEQ;
      pb_rows<4>(F, INP(I_X) + (size_t)row0 * D, row0, INP(I_GMIX), mod + b * 6144, mod + b * 6144 + 1024);
      pb_rows<4>(F, INP(I_X) + (size_t)(row0 + 4) * D, row0 + 4, INP(I_GMIX), mod + b * 6144, mod + b * 6144 + 1024); }
    if (gw < NCTX) pb_rows<1>(F, INP(I_CTX) + (size_t)gw * D, NLAT + gw, INP(I_GMIX), mod + 4 * 6144, mod + 4 * 6144 + 1024);
    __syncthreads();
}

__device__ __forceinline__ void phase_c(Frame& F) {
    pg8::Gemm g{WSP(bf16, WS_H), WSP(bf16, WS_WINT), 1024};
    pg8::InProjOrder S; S.init(F.G, (int)blockIdx.x);
    pg8::EpiInProj E{WSP(bf16, WS_P), WSP(bf16, WS_PCTX)};
    pg8::gemm_phase(F.lds, g, S, E);
}

__device__ __forceinline__ void gate_tables(Frame& F, const float* gates_row0, int h, float mprevF, float mprevB) {
    LAS float* T = (LAS float*)(F.lds + TAB_OFF);
    const int tid = F.tid, lane = F.lane;
    if (tid < 128) {
        const float* gr = gates_row0 + (size_t)tid * 16;
        const float bi0 = INP(I_BI)[h], bi1 = INP(I_BI)[4 + h], bf0 = INP(I_BF)[h], bf1 = INP(I_BF)[4 + h];
        T[tid] = gr[h] + bi0; T[128 + tid] = logsig_f(gr[8 + h] + bf0);
        T[256 + tid] = gr[4 + h] + bi1; T[384 + tid] = logsig_f(gr[12 + h] + bf1);
    }
    __syncthreads();
    if (F.wave < 2) {
        const int dir = F.wave;
        const float mprev = dir ? mprevB : mprevF;
        const int s0 = dir ? 127 - 2 * lane : 2 * lane, s1 = dir ? 126 - 2 * lane : 2 * lane + 1;
        const int lio = dir ? 256 : 0, lfo = dir ? 384 : 128, uo = dir ? 768 : 512, mo = dir ? 896 : 640, co = dir ? 1280 : 1152;
        const float lf0 = T[lfo + s0], lf1 = T[lfo + s1], li0 = T[lio + s0], li1 = T[lio + s1];
        float S = lf0 + lf1;
#pragma unroll
        for (int o = 1; o < 64; o <<= 1) { const float t = __shfl_up(S, o); if (lane >= o) S += t; }
        const float c1 = S, c0 = S - lf1;
        const float u0 = li0 - c0, u1 = li1 - c1;
        float Mx = fmaxf(u0, u1);
#pragma unroll
        for (int o = 1; o < 64; o <<= 1) { const float t = __shfl_up(Mx, o); if (lane >= o) Mx = fmaxf(Mx, t); }
        float prev = __shfl_up(Mx, 1); if (lane == 0) prev = -INFINITY;
        T[uo + s0] = u0; T[uo + s1] = u1; T[mo + s0] = fmaxf(mprev, fmaxf(prev, u0)); T[mo + s1] = fmaxf(mprev, Mx); T[co + s0] = c0; T[co + s1] = c1;
        if (lane == 63) { T[1024 + 2 * dir] = c1; T[1025 + 2 * dir] = Mx; }
        if (lane == 0) T[1028 + dir] = mprev;
    }
    __syncthreads();
}

__device__ __forceinline__ void conv_silu8(const bf16* base, size_t pitch, int spos, int seqlen, const float* cw  , float scale, float (&o)[8]) {
    const u32x4 z = {0u, 0u, 0u, 0u};
    const u32x4 v0 = (spos > 0) ? *(const u32x4*)(base - pitch) : z;
    const u32x4 v1 = *(const u32x4*)(base);
    const u32x4 v2 = (spos + 1 < seqlen) ? *(const u32x4*)(base + pitch) : z;
    const f32x4 w0a = *(const f32x4*)(cw), w0b = *(const f32x4*)(cw + 4), w1a = *(const f32x4*)(cw + 512), w1b = *(const f32x4*)(cw + 516), w2a = *(const f32x4*)(cw + 1024), w2b = *(const f32x4*)(cw + 1028);
    const float x0[8] = {bflo(v0.x), bfhi(v0.x), bflo(v0.y), bfhi(v0.y), bflo(v0.z), bfhi(v0.z), bflo(v0.w), bfhi(v0.w)};
    const float x1[8] = {bflo(v1.x), bfhi(v1.x), bflo(v1.y), bfhi(v1.y), bflo(v1.z), bfhi(v1.z), bflo(v1.w), bfhi(v1.w)};
    const float x2[8] = {bflo(v2.x), bfhi(v2.x), bflo(v2.y), bfhi(v2.y), bflo(v2.z), bfhi(v2.z), bflo(v2.w), bfhi(v2.w)};
    const float w0[8] = {w0a[0], w0a[1], w0a[2], w0a[3], w0b[0], w0b[1], w0b[2], w0b[3]};
    const float w1[8] = {w1a[0], w1a[1], w1a[2], w1a[3], w1b[0], w1b[1], w1b[2], w1b[3]};
    const float w2[8] = {w2a[0], w2a[1], w2a[2], w2a[3], w2b[0], w2b[1], w2b[2], w2b[3]};
#pragma unroll
    for (int e = 0; e < 8; ++e) o[e] = silu_f(x0[e] * w0[e] + x1[e] * w1[e] + x2[e] * w2[e]) * scale;
}

__device__ __forceinline__ void pd_mlstm_item(Frame& F, int it) {
    int tid = F.tid, lane = F.lane; const int wave = F.wave;
    asm volatile("" : "+v"(tid), "+v"(lane));
    int b, h, c, seqlen, jf, jb; const bf16* kbase; const bf16* vbase; size_t pitch; const float* grow;
    if (it < 512) { b = it >> 7; h = (it >> 5) & 3; c = it & 31; seqlen = SEQ; pitch = PW;
        const size_t row0 = (size_t)b * SEQ + c * 128; kbase = WSP(bf16, WS_P) + row0 * PW + 2048 + h * 128; vbase = kbase + 512;
        grow = WSP(float, WS_GATES) + row0 * 16; jf = 2 + c; jb = 2 + (31 - c); }
    else { const int q = it - 512; b = q >> 3; h = (q >> 1) & 3; c = q & 1; seqlen = CTXL; pitch = 1024;
        const size_t row0 = (size_t)b * CTXL + c * 128; kbase = WSP(bf16, WS_PCTX) + row0 * 1024 + h * 128; vbase = kbase + 512;
        grow = WSP(float, WS_GATES) + ((size_t)NLAT + row0) * 16; jf = c; jb = 1 - c; }
    gate_tables(F, grow, h, 0.f, 0.f);
    LAS float* T = (LAS float*)(F.lds + TAB_OFF);
    const float umF = T[1025], umB = T[1027];
    ldsp TV = F.lds, TKF = F.lds + TILE_BYTES, TKB = F.lds + 2 * TILE_BYTES;
    load_tile(TV, vbase, pitch, tid);
#pragma unroll 1
    for (int i = 0; i < 4; ++i) { const int q = tid + 512 * i, s = q >> 4, ch = q & 15;
        float kk[8]; conv_silu8(kbase + (size_t)s * pitch + ch * 8, pitch, c * 128 + s, seqlen, INP(I_CONVK) + h * 128 + ch * 8, 0.08838834764831845f, kk);
        const float wf = fexp(T[512 + s] - umF), wb = fexp(T[768 + s] - umB);
        u32x4 of, ob;
        of.x = pk2(kk[0] * wf, kk[1] * wf); of.y = pk2(kk[2] * wf, kk[3] * wf); of.z = pk2(kk[4] * wf, kk[5] * wf); of.w = pk2(kk[6] * wf, kk[7] * wf);
        ob.x = pk2(kk[0] * wb, kk[1] * wb); ob.y = pk2(kk[2] * wb, kk[3] * wb); ob.z = pk2(kk[4] * wb, kk[5] * wb); ob.w = pk2(kk[6] * wb, kk[7] * wb);
        *(LAS u32x4*)(TKF + toff(s, ch)) = of; *(LAS u32x4*)(TKB + toff(s, ch)) = ob; }
    __syncthreads();
    const int scanF = (b * 4 + h) * 2, scanB = scanF + 1;
    const size_t slotF = (size_t)scanF * NSTEP + jf, slotB = (size_t)scanB * NSTEP + jb;
    if (tid == 0) { float* sc = WSP(float, WS_SC); sc[slotF * 2] = T[1024]; sc[slotF * 2 + 1] = T[1025]; sc[slotB * 2] = T[1026]; sc[slotB * 2 + 1] = T[1027]; }
    const int rb = wave >> 1, cb0 = 2 * (wave & 1);
#pragma unroll 1
    for (int dir = 0; dir < 2; ++dir) {
        f32x16 acc[2]; acc[0] = (f32x16)(0.f); acc[1] = (f32x16)(0.f);
        if (rb == 0) {
            f32x16 e0 = (f32x16)(0.f), e1 = (f32x16)(0.f);
            mm128x<true, true, EXT_ONES_A>(acc, TV, dir ? TKB : TKF, wave, lane, e0, e1, TV);
            if (lane < 32) { float* dn = WSP(float, WS_DN) + (dir ? slotB : slotF) * 128 + 32 * cb0 + lane; dn[0] = e0[0]; dn[32] = e1[0]; }
        } else mm128<true, true>(acc, TV, dir ? TKB : TKF, wave, lane);
        float* dc = WSP(float, WS_DC) + (dir ? slotB : slotF) * 16384;
#pragma unroll
        for (int cbi = 0; cbi < 2; ++cbi)
#pragma unroll
            for (int r = 0; r < 16; ++r) dc[ACC_ROW(rb, r, lane) * 128 + 32 * (cb0 + cbi) + (lane & 31)] = acc[cbi][r];
    }
    __syncthreads();
}
__device__ __forceinline__ void pd_gmlp_item(Frame& F, int it) {
    int tid = F.tid, lane = F.lane; const int wave = F.wave;
    asm volatile("" : "+v"(tid), "+v"(lane));
    const int b = it >> 7, c = (it >> 2) & 31, h = it & 3;
    const size_t row0 = (size_t)b * SEQ + c * 128;
    const bf16* P = WSP(bf16, WS_P);
    ldsp TA = F.lds, TV = F.lds + TILE_BYTES, TO = F.lds + 2 * TILE_BYTES;
    load_tile(TA, WSP(bf16, WS_WSB) + h * 16384, 128, tid);
    {
        const int q = tid >> 2, part = tid & 3;
        const bf16* vr = P + (row0 + q) * PW + 512 + part * 128;
        float s1 = 0.f, s2 = 0.f;
#pragma unroll 4
        for (int i = 0; i < 16; ++i) { const u32x4 v = *(const u32x4*)(vr + 8 * i);
            const float g0 = gelu_f(bflo(v.x)), g1 = gelu_f(bfhi(v.x)), g2 = gelu_f(bflo(v.y)), g3 = gelu_f(bfhi(v.y)), g4 = gelu_f(bflo(v.z)), g5 = gelu_f(bfhi(v.z)), g6 = gelu_f(bflo(v.w)), g7 = gelu_f(bfhi(v.w));
            s1 += ((g0 + g1) + (g2 + g3)) + ((g4 + g5) + (g6 + g7));
            s2 += ((g0 * g0 + g1 * g1) + (g2 * g2 + g3 * g3)) + ((g4 * g4 + g5 * g5) + (g6 * g6 + g7 * g7)); }
        s1 += __shfl_xor(s1, 1); s1 += __shfl_xor(s1, 2); s2 += __shfl_xor(s2, 1); s2 += __shfl_xor(s2, 2);
        const float mu = s1 * (1.f / 512.f), var = fmaxf(s2 * (1.f / 512.f) - mu * mu, 0.f), rstd = rsqrtf(var + EPS);
        const bf16* hr = P + (row0 + q) * PW + 512 + h * 128 + part * 32;
#pragma unroll
        for (int i = 0; i < 4; ++i) { const u32x4 v = *(const u32x4*)(hr + 8 * i);
            u32x4 o;
            o.x = pk2((gelu_f(bflo(v.x)) - mu) * rstd, (gelu_f(bfhi(v.x)) - mu) * rstd); o.y = pk2((gelu_f(bflo(v.y)) - mu) * rstd, (gelu_f(bfhi(v.y)) - mu) * rstd);
            o.z = pk2((gelu_f(bflo(v.z)) - mu) * rstd, (gelu_f(bfhi(v.z)) - mu) * rstd); o.w = pk2((gelu_f(bflo(v.w)) - mu) * rstd, (gelu_f(bfhi(v.w)) - mu) * rstd);
            *(LAS u32x4*)(TV + toff(q, part * 4 + i)) = o; }
    }
    __syncthreads();
    f32x16 acc[2]; acc[0] = (f32x16)(0.f); acc[1] = (f32x16)(0.f);
    mm128<false, true>(acc, TA, TV, wave, lane);
    const int rb = wave >> 1, cb0 = 2 * (wave & 1);
#pragma unroll
    for (int cbi = 0; cbi < 2; ++cbi)
#pragma unroll
        for (int r = 0; r < 16; ++r) { const int p = ACC_ROW(rb, r, lane), d = 32 * (cb0 + cbi) + (lane & 31);
            const float u = gelu_f(bf2f(P[(row0 + p) * PW + h * 128 + d]));
            const float y = u * (acc[cbi][r] + INP(I_GBS)[h * 128 + p]);
            *(LAS unsigned short*)(TO + toff(p, d >> 3) + 2 * (d & 7)) = (unsigned short)f2bf(y); }
    __syncthreads();
    store_tile(TO, WSP(bf16, WS_YMIX) + row0 * D + h * 128, D, tid);
    __syncthreads();
}
__device__ __forceinline__ void phase_d(Frame& F) {
    int it = F.vcu;
#pragma unroll 1
    for (; it < 544; it += F.G) pd_mlstm_item(F, it);
    asm volatile("" ::: "memory");
#pragma unroll 1
    for (; it < 768; it += F.G) pd_gmlp_item(F, it - 544);
}

__device__ __forceinline__ void phase_e(Frame& F) {
    const int tid = F.tid, scan = F.vcu >> 3, slice = F.vcu & 7;
    {
        const float* sc = WSP(float, WS_SC) + (size_t)scan * NSTEP * 2;
        const int v = slice * 16 + (tid >> 5), d = (tid & 31) * 4;
        const float* dc = WSP(float, WS_DC) + (size_t)scan * NSTEP * 16384 + v * 128 + d;
        const float* dn = WSP(float, WS_DN) + (size_t)scan * NSTEP * 128;
        bf16* cst = WSP(bf16, WS_CST) + (size_t)scan * 32 * 16384 + v * 128 + d;
        const bool don = (slice == 0 && tid < 128);
        f32x4 dcv[33]; float dnv[33];
#pragma unroll
        for (int j = 0; j <= 32; ++j) { dcv[j] = *(const f32x4*)(dc + (size_t)j * 16384); dnv[j] = don ? dn[j * 128 + tid] : 0.f; }
        f32x4 C = {0.f, 0.f, 0.f, 0.f}; float n = 0.f, m = 0.f;
#pragma unroll
        for (int j = 0; j <= 32; ++j) {
            const float BL = sc[2 * j], UM = sc[2 * j + 1];
            const float M = fmaxf(m, UM), a = fexp(m - M), bb = fexp(UM - M);
            C = C * a + dcv[j] * bb;
            n = n * a + dnv[j] * bb;
            m = BL + M;
            if (j >= 1) {
                u32x2 o; o.x = pk2(C[0], C[1]); o.y = pk2(C[2], C[3]);
                *(u32x2*)(cst + (size_t)(j - 1) * 16384) = o;
                if (don) WSP(float, WS_NST)[((size_t)scan * 32 + (j - 1)) * 128 + tid] = n;
                if (slice == 0 && tid == 0) WSP(float, WS_MST)[scan * 32 + (j - 1)] = m;
            }
        }
    }
    asm volatile("" ::: "memory");
#pragma unroll 1
    for (int it = 224 + F.vcu; it < 512; it += F.G) pd_gmlp_item(F, it);
}

__device__ __forceinline__ void pf_item(Frame& F, int it) {
    int tid = F.tid, lane = F.lane; const int wave = F.wave;
    asm volatile("" : "+v"(tid), "+v"(lane));
    const int b = it >> 7, h = (it >> 5) & 3, c = it & 31;
    const size_t row0 = (size_t)b * SEQ + c * 128;
    const bf16* P = WSP(bf16, WS_P);
    const int scanF = (b * 4 + h) * 2, scanB = scanF + 1, stF = c, stB = 31 - c;
    const float mpF = WSP(float, WS_MST)[scanF * 32 + stF], mpB = WSP(float, WS_MST)[scanB * 32 + stB];
    gate_tables(F, WSP(float, WS_GATES) + row0 * 16, h, mpF, mpB);
    LAS float* T = (LAS float*)(F.lds + TAB_OFF);
    if (tid < 256) { const int dir = tid >> 7, d = tid & 127; ((LAS unsigned short*)(T + 1408))[tid] = (unsigned short)f2bf(WSP(float, WS_NST)[((size_t)(dir ? scanB : scanF) * 32 + (dir ? stB : stF)) * 128 + d]); }
    ldsp TQ = F.lds, TX = F.lds + TILE_BYTES, TV = F.lds + 2 * TILE_BYTES, TY = F.lds + 3 * TILE_BYTES;
    load_tile(TV, P + row0 * PW + 2560 + h * 128, PW, tid);
#pragma unroll 1
    for (int i = 0; i < 4; ++i) { const int q = tid + 512 * i, s = q >> 4, ch = q & 15;
        float qq[8], kk[8];
        conv_silu8(P + (row0 + s) * PW + 1024 + h * 128 + ch * 8, PW, c * 128 + s, SEQ, INP(I_CONVQ) + h * 128 + ch * 8, 1.f, qq);
        conv_silu8(P + (row0 + s) * PW + 2048 + h * 128 + ch * 8, PW, c * 128 + s, SEQ, INP(I_CONVK) + h * 128 + ch * 8, 0.08838834764831845f, kk);
        u32x4 oq, ok;
        oq.x = pk2(qq[0], qq[1]); oq.y = pk2(qq[2], qq[3]); oq.z = pk2(qq[4], qq[5]); oq.w = pk2(qq[6], qq[7]);
        ok.x = pk2(kk[0], kk[1]); ok.y = pk2(kk[2], kk[3]); ok.z = pk2(kk[4], kk[5]); ok.w = pk2(kk[6], kk[7]);
        *(LAS u32x4*)(TQ + toff(s, ch)) = oq; *(LAS u32x4*)(TX + toff(s, ch)) = ok; }
    __syncthreads();
    const int rb = wave >> 1, cb0 = 2 * (wave & 1);
    f32x16 qk[2]; qk[0] = (f32x16)(0.f); qk[1] = (f32x16)(0.f);
    mm128<false, false>(qk, TQ, TX, wave, lane);
    __syncthreads();
    f32x16 hacc[2]; hacc[0] = (f32x16)(0.f); hacc[1] = (f32x16)(0.f);
#pragma unroll 1
    for (int dir = 0; dir < 2; ++dir) {
        const int uo = dir ? 768 : 512, mo = dir ? 896 : 640;
        int lane2 = lane; asm volatile("" : "+v"(lane2));
#pragma unroll
        for (int cbi = 0; cbi < 2; ++cbi)
#pragma unroll
            for (int r = 0; r < 16; ++r) { const int t = ACC_ROW(rb, r, lane2), s = 32 * (cb0 + cbi) + (lane2 & 31);
                const bool keep = dir ? (s >= t) : (s <= t);
                const float pv = keep ? qk[cbi][r] * fexp(T[uo + s] - T[mo + t]) : 0.f;
                *(LAS unsigned short*)(TX + toff(t, s >> 3) + 2 * (s & 7)) = (unsigned short)f2bf(pv);
                if ((r & 3) == 3) asm volatile("" ::: "memory"); }
        load_tile(TY, WSP(bf16, WS_CST) + ((size_t)(dir ? scanB : scanF) * 32 + (dir ? stB : stF)) * 16384, 128, tid);
        __syncthreads();
        f32x16 acc[2], qn, rs, dmy; acc[0] = (f32x16)(0.f); acc[1] = (f32x16)(0.f); qn = (f32x16)(0.f); rs = (f32x16)(0.f);
        mm128x<false, false, EXT_VEC_B>(acc, TQ, TY, wave, lane, qn, dmy, (ldscp)(F.lds + TAB_OFF + 1408 * 4 + 256 * dir));
        const float mp = dir ? mpB : mpF;
        float inter[16];
#pragma unroll
        for (int r = 0; r < 16; ++r) { inter[r] = fexp(mp - T[mo + ACC_ROW(rb, r, lane2)]); acc[0][r] *= inter[r]; acc[1][r] *= inter[r]; }
        mm128x<false, true, EXT_ONES_B>(acc, TX, TV, wave, lane, rs, dmy, TX);
#pragma unroll
        for (int r = 0; r < 16; ++r) { const int t = ACC_ROW(rb, r, lane2); const float den = inter[r] * qn[r] + rs[r], flo = fexp(-T[(dir ? 1280 : 1152) + t] - T[mo + t]);
            const float inv = frcp(fmaxf(fabsf(den), flo)); hacc[0][r] += acc[0][r] * inv; hacc[1][r] += acc[1][r] * inv; }
        __syncthreads();
    }
    LAS float* HB = (LAS float*)TX;
#pragma unroll
    for (int cbi = 0; cbi < 2; ++cbi)
#pragma unroll
        for (int r = 0; r < 16; ++r) HB[ACC_ROW(rb, r, lane) * 132 + 32 * (cb0 + cbi) + (lane & 31)] = hacc[cbi][r];
    __syncthreads();
    { const int t = tid >> 2, part = tid & 3; float x[32]; float s1 = 0.f;
#pragma unroll
      for (int i = 0; i < 8; ++i) { const f32x4 v = *(const LAS f32x4*)(HB + t * 132 + part * 32 + 4 * i); x[4 * i] = v[0]; x[4 * i + 1] = v[1]; x[4 * i + 2] = v[2]; x[4 * i + 3] = v[3]; s1 += (v[0] + v[1]) + (v[2] + v[3]); }
      s1 += __shfl_xor(s1, 1); s1 += __shfl_xor(s1, 2);
      const float mu = s1 * (1.f / 128.f); float s2 = 0.f;
#pragma unroll
      for (int i = 0; i < 32; ++i) { x[i] -= mu; s2 += x[i] * x[i]; }
      s2 += __shfl_xor(s2, 1); s2 += __shfl_xor(s2, 2);
      const float rstd = rsqrtf(s2 * (1.f / 128.f) + EPS);
      const bf16* orow = P + (row0 + t) * PW + 1536 + h * 128 + part * 32;
      const float* ng = INP(I_MNG) + h * 128 + part * 32;
      bf16* yrow = WSP(bf16, WS_YMIX) + (row0 + t) * D + 512 + h * 128 + part * 32;
#pragma unroll
      for (int i = 0; i < 4; ++i) { const u32x4 ov = *(const u32x4*)(orow + 8 * i); const f32x4 g0 = *(const f32x4*)(ng + 8 * i), g1 = *(const f32x4*)(ng + 8 * i + 4);
          const float y0 = x[8 * i] * rstd * g0[0] * sigmoid_f(bflo(ov.x)), y1 = x[8 * i + 1] * rstd * g0[1] * sigmoid_f(bfhi(ov.x));
          const float y2 = x[8 * i + 2] * rstd * g0[2] * sigmoid_f(bflo(ov.y)), y3 = x[8 * i + 3] * rstd * g0[3] * sigmoid_f(bfhi(ov.y));
          const float y4 = x[8 * i + 4] * rstd * g1[0] * sigmoid_f(bflo(ov.z)), y5 = x[8 * i + 5] * rstd * g1[1] * sigmoid_f(bfhi(ov.z));
          const float y6 = x[8 * i + 6] * rstd * g1[2] * sigmoid_f(bflo(ov.w)), y7 = x[8 * i + 7] * rstd * g1[3] * sigmoid_f(bfhi(ov.w));
          u32x4 o; o.x = pk2(y0, y1); o.y = pk2(y2, y3); o.z = pk2(y4, y5); o.w = pk2(y6, y7);
          *(u32x4*)(yrow + 8 * i) = o; } }
    __syncthreads();
}
__device__ __forceinline__ void phase_f(Frame& F) { for (int it = F.vcu; it < 512; it += F.G) pf_item(F, it); }

__device__ __forceinline__ void phase_g(Frame& F) {
    pg8::Gemm g{WSP(bf16, WS_YMIX), WSP(bf16, WS_WOUTT), 1024};
    pg8::DenseOrder S; S.init(64, 4, F.G, (int)blockIdx.x);
    pg8::EpiOut E{INP(I_X), F.p->out, WSP(float, WS_MOD)};
    pg8::gemm_phase(F.lds, g, S, E);
}

__device__ __forceinline__ void ph_rows4(Frame& F, int row0, int b) {
    const int lane = F.lane;
    const float* mod = WSP(float, WS_MOD) + b * 6144;
    float gs[16], sh[16];
#pragma unroll
    for (int j = 0; j < 4; ++j) { const f32x4 g4 = *(const f32x4*)(INP(I_GFFN) + 256 * j + 4 * lane), s4 = *(const f32x4*)(mod + 4096 + 256 * j + 4 * lane), h4 = *(const f32x4*)(mod + 3072 + 256 * j + 4 * lane);
#pragma unroll
        for (int i = 0; i < 4; ++i) { gs[4 * j + i] = g4[i] * (1.f + s4[i]); sh[4 * j + i] = h4[i]; } }
    float hv[4][16];
#pragma unroll
    for (int r = 0; r < 4; ++r)
#pragma unroll
        for (int j = 0; j < 4; ++j) { const f32x4 v = *(const f32x4*)(F.p->out + (size_t)(row0 + r) * D + 256 * j + 4 * lane); hv[r][4 * j] = v[0]; hv[r][4 * j + 1] = v[1]; hv[r][4 * j + 2] = v[2]; hv[r][4 * j + 3] = v[3]; }
#pragma unroll
    for (int r = 0; r < 4; ++r) {
        float ss = 0.f;
#pragma unroll
        for (int q = 0; q < 16; ++q) ss += hv[r][q] * hv[r][q];
        const float rr = rsqrtf(wave_sum(ss) * (1.f / D) + EPS);
        bf16* hrow = WSP(bf16, WS_H) + (size_t)(row0 + r) * D;
#pragma unroll
        for (int j = 0; j < 4; ++j) {
#pragma unroll
            for (int i = 0; i < 4; ++i) hv[r][4 * j + i] = hv[r][4 * j + i] * rr * gs[4 * j + i] + sh[4 * j + i];
            u32x2 o; o.x = pk2(hv[r][4 * j], hv[r][4 * j + 1]); o.y = pk2(hv[r][4 * j + 2], hv[r][4 * j + 3]);
            *(u32x2*)(hrow + 256 * j + 4 * lane) = o; }
    }
    float lg[4];
    row16<4>(F.lds, hv, lg, lane);
#pragma unroll
    for (int r = 0; r < 4; ++r) {
        float mx = lg[r];
        mx = fmaxf(mx, __shfl_xor(mx, 4)); mx = fmaxf(mx, __shfl_xor(mx, 8)); mx = fmaxf(mx, __shfl_xor(mx, 16)); mx = fmaxf(mx, __shfl_xor(mx, 32));
        const float e = fexp(lg[r] - mx); float sum = e;
        sum += __shfl_xor(sum, 4); sum += __shfl_xor(sum, 8); sum += __shfl_xor(sum, 16); sum += __shfl_xor(sum, 32);
        const int t = (row0 + r) & (SEQ - 1);
        if ((lane & 3) == 0) WSP(float, WS_AFFT)[((size_t)b * 16 + IDX16(lane)) * SEQ + t] = e / sum;
    }
}
__device__ __forceinline__ void phase_h(Frame& F) {
    stage_w16(F.lds, INP(I_WR), 16, F.tid);
    __syncthreads();
    const int gw = F.vcu * 8 + F.wave, row0 = gw * 8, b = row0 / SEQ;
    ph_rows4(F, row0, b); ph_rows4(F, row0 + 4, b);
    __syncthreads();
}

__device__ __forceinline__ void phase_i(Frame& F) {
    const int tid = F.tid, lane = F.lane, wave = F.wave;
    if (F.vcu >= 64) return;
    const int b = F.vcu >> 4, e = F.vcu & 15;
    LAS unsigned* hist = (LAS unsigned*)F.lds;
    LAS unsigned* hist2 = hist + 256;
    LAS unsigned* sel = hist + 512;
    LAS unsigned* wsum = hist + 520;
    LAS int* lidx = (LAS int*)(F.lds + 4096);
    const float* aff = WSP(float, WS_AFFT) + ((size_t)b * 16 + e) * SEQ;
    unsigned key[8];
    { const u32x4 v0 = *(const u32x4*)(aff + tid * 8), v1 = *(const u32x4*)(aff + tid * 8 + 4); key[0] = v0.x; key[1] = v0.y; key[2] = v0.z; key[3] = v0.w; key[4] = v1.x; key[5] = v1.y; key[6] = v1.z; key[7] = v1.w; }
    unsigned prefix = 0u, mask = 0u, need = CAP;
    for (int pass = 3; pass >= 0; --pass) {
        const int shift = 8 * pass;
        if (tid < 256) hist[tid] = 0u;
        __syncthreads();
#pragma unroll
        for (int i = 0; i < 8; ++i) if ((key[i] & mask) == prefix) atomicAdd((unsigned*)&hist[(key[i] >> shift) & 255u], 1u);
        __syncthreads();
        LAS unsigned* A = hist; LAS unsigned* Bv = hist2;
        for (int ofs = 1; ofs < 256; ofs <<= 1) {
            if (tid < 256) Bv[tid] = A[tid] + ((tid + ofs < 256) ? A[tid + ofs] : 0u);
            __syncthreads();
            LAS unsigned* tsw = A; A = Bv; Bv = tsw;
        }
        if (tid < 256) { const unsigned sb = A[tid], sn = (tid < 255) ? A[tid + 1] : 0u; if (sb >= need && sn < need) { sel[0] = (unsigned)tid; sel[1] = need - sn; } }
        __syncthreads();
        prefix |= sel[0] << shift; mask |= 255u << shift; need = sel[1];
        __syncthreads();
    }
    int cg = 0, ce = 0;
#pragma unroll
    for (int i = 0; i < 8; ++i) { cg += (key[i] > prefix) ? 1 : 0; ce += (key[i] == prefix) ? 1 : 0; }
    int sg = cg, se = ce;
#pragma unroll
    for (int o = 1; o < 64; o <<= 1) { const int tg = __shfl_up(sg, o), te = __shfl_up(se, o); if (lane >= o) { sg += tg; se += te; } }
    if (lane == 63) { wsum[wave] = (unsigned)sg; wsum[8 + wave] = (unsigned)se; }
    __syncthreads();
    int baseg = 0, basee = 0, totg = 0;
#pragma unroll
    for (int w = 0; w < 8; ++w) { const int g = (int)wsum[w], q = (int)wsum[8 + w]; if (w < wave) { baseg += g; basee += q; } totg += g; }
    int pg = baseg + sg - cg, pe = basee + se - ce;
    int* slotmap = WSP(int, WS_SLOT) + ((size_t)b * SEQ + tid * 8) * 16 + e;
    float* gatev = WSP(float, WS_GATEV) + ((size_t)e * 4 + b) * CAP;
#pragma unroll
    for (int i = 0; i < 8; ++i) {
        int slot = -1;
        if (key[i] > prefix) slot = pg++;
        else if (key[i] == prefix) { if (pe < (int)need) slot = totg + pe; ++pe; }
        slotmap[i * 16] = slot;
        if (slot >= 0) { lidx[slot] = tid * 8 + i; gatev[slot] = __builtin_bit_cast(float, key[i]); }
    }
    __syncthreads();
    const bf16* H2 = WSP(bf16, WS_H) + (size_t)b * SEQ * D;
    bf16* XE = WSP(bf16, WS_XE) + ((size_t)e * 4 + b) * CAP * D;
    for (int slot = wave; slot < CAP; slot += 8) { const int t = lidx[slot];
        const u32x4* src = (const u32x4*)(H2 + (size_t)t * D); u32x4* dst = (u32x4*)(XE + (size_t)slot * D);
        const u32x4 v0 = src[lane], v1 = src[lane + 64]; dst[lane] = v0; dst[lane + 64] = v1; }
    __syncthreads();
}

__device__ __forceinline__ void phase_j(Frame& F) {
    pg8::Gemm g{WSP(bf16, WS_XE), WSP(bf16, WS_WE1), 1024};
    pg8::GroupedOrder S; S.init(8, 16, F.G, (int)blockIdx.x);
    pg8::EpiGU E{WSP(bf16, WS_HID)};
    pg8::gemm_phase(F.lds, g, S, E);
}
__device__ __forceinline__ void phase_k(Frame& F) {
    pg8::Gemm g{WSP(bf16, WS_HID), WSP(bf16, WS_WE2), 2048};
    pg8::GroupedOrder S; S.init(8, 4, F.G, (int)blockIdx.x);
    pg8::EpiDown E{WSP(bf16, WS_YE), WSP(float, WS_GATEV)};
    pg8::gemm_phase(F.lds, g, S, E);
}

__device__ __forceinline__ void phase_l(Frame& F) {
    const int lane = F.lane, gw = F.vcu * 8 + F.wave, row0 = gw * 8, b = row0 / SEQ;
    const float* mod = WSP(float, WS_MOD) + b * 6144 + 5120;
    const bf16* YEb = WSP(bf16, WS_YE) + (size_t)b * CAP * D + 4 * lane;
    const int* slotp = WSP(int, WS_SLOT) + (size_t)row0 * 16 + (lane & 15);
    float* xr0 = F.p->out + (size_t)row0 * D + 4 * lane;
    f32x4 g2[4], fg[4], xn[4];
#pragma unroll
    for (int j = 0; j < 4; ++j) { g2[j] = *(const f32x4*)(mod + 4 * lane + 256 * j); fg[j] = *(const f32x4*)(INP(I_GFIN) + 4 * lane + 256 * j); xn[j] = *(const f32x4*)(xr0 + 256 * j); }
    int sln = slotp[0];
#pragma unroll 1
    for (int rr = 0; rr < 8; ++rr) {
        f32x4 x[4], a[4]; const int sl = (lane < 16) ? sln : -1;
#pragma unroll
        for (int j = 0; j < 4; ++j) { x[j] = xn[j]; a[j] = (f32x4){0.f, 0.f, 0.f, 0.f}; }
        float* xr = xr0 + (size_t)rr * D;
        if (rr < 7) {
#pragma unroll
            for (int j = 0; j < 4; ++j) xn[j] = *(const f32x4*)(xr + D + 256 * j);
            sln = slotp[(rr + 1) * 16];
        }
        unsigned mask = (unsigned)__ballot(sl >= 0) & 0xFFFFu;
        while (mask) {
            const int e0 = __builtin_ctz(mask); mask &= mask - 1;
            const int s0 = __builtin_amdgcn_readlane(sl, e0);
            const bf16* y0 = YEb + ((size_t)e0 * 4 * CAP + s0) * D;
            if (mask) {
                const int e1 = __builtin_ctz(mask); mask &= mask - 1;
                const int s1 = __builtin_amdgcn_readlane(sl, e1);
                const bf16* y1 = YEb + ((size_t)e1 * 4 * CAP + s1) * D;
                u32x2 v0[4], v1[4];
#pragma unroll
                for (int j = 0; j < 4; ++j) { v0[j] = *(const u32x2*)(y0 + 256 * j); v1[j] = *(const u32x2*)(y1 + 256 * j); }
#pragma unroll
                for (int j = 0; j < 4; ++j) { a[j][0] += bflo(v0[j].x) + bflo(v1[j].x); a[j][1] += bfhi(v0[j].x) + bfhi(v1[j].x); a[j][2] += bflo(v0[j].y) + bflo(v1[j].y); a[j][3] += bfhi(v0[j].y) + bfhi(v1[j].y); }
            } else {
                u32x2 v0[4];
#pragma unroll
                for (int j = 0; j < 4; ++j) v0[j] = *(const u32x2*)(y0 + 256 * j);
#pragma unroll
                for (int j = 0; j < 4; ++j) { a[j][0] += bflo(v0[j].x); a[j][1] += bfhi(v0[j].x); a[j][2] += bflo(v0[j].y); a[j][3] += bfhi(v0[j].y); }
            }
        }
        float ss = 0.f;
#pragma unroll
        for (int j = 0; j < 4; ++j) { x[j] = x[j] + g2[j] * a[j]; ss += (x[j][0] * x[j][0] + x[j][1] * x[j][1]) + (x[j][2] * x[j][2] + x[j][3] * x[j][3]); }
        const float r = rsqrtf(wave_sum(ss) * (1.f / D) + EPS);
#pragma unroll
        for (int j = 0; j < 4; ++j) *(f32x4*)(xr + 256 * j) = x[j] * r * fg[j];
    }
}

__global__ void __launch_bounds__(512, 2) mk_fwd(Params prm) {
    extern __shared__ __attribute__((aligned(16))) unsigned char lds_raw[];
    Frame F;
    F.lds = (ldsp)lds_raw; F.tid = threadIdx.x; F.lane = F.tid & 63; F.wave = __builtin_amdgcn_readfirstlane(F.tid >> 6);
    F.G = gridDim.x; { const int bx = blockIdx.x; F.vcu = (F.G % 8 == 0) ? (bx % 8) * (F.G / 8) + bx / 8 : bx; }
    F.p = &prm;
    volatile LAS unsigned* MISC = (volatile LAS unsigned*)(F.lds + MISC_OFF);
    if (F.tid < 32) MISC[F.tid] = 0u;
    __syncthreads();
    const int lo = prm.ph_lo, hi = prm.ph_hi;
    XcdBarrier bar; bar.bar = (unsigned*)(prm.ws + WS_CTL) + 1024; bar.x = 0; bar.st = nullptr;
    if (hi - lo > 1) bar = xcd_barrier_post((unsigned*)(prm.ws + WS_CTL) + 1024, MISC + 8);
#ifdef ONLY_PHASE
#define IN(k) ((k) == ONLY_PHASE && lo <= (k) && (k) < hi)
#else
#define IN(k) (lo <= (k) && (k) < hi)
#endif
#define SEAM(k) do { if (IN(k) && IN((k) + 1)) xcd_barrier(bar); } while (0)
#ifndef REPEAT_MASK
#define REPEAT_MASK 0
#endif
#define RUN(k, call) do { if (IN(k)) { call; if ((REPEAT_MASK >> (k)) & 1) { xcd_barrier(bar); call; } } } while (0)
    RUN(0, phase_a(F));  SEAM(0);
#ifdef EXTRA_BARS
    for (int q = 0; q < EXTRA_BARS; ++q) xcd_barrier(bar);
#endif
    RUN(1, phase_b(F));  SEAM(1);
    RUN(2, phase_c(F));  SEAM(2);
    RUN(3, phase_d(F));  SEAM(3);
    RUN(4, phase_e(F));  SEAM(4);
    RUN(5, phase_f(F));  SEAM(5);
    RUN(6, phase_g(F));  SEAM(6);
    RUN(7, phase_h(F));  SEAM(7);
    RUN(8, phase_i(F));  SEAM(8);
    RUN(9, phase_j(F));  SEAM(9);
    RUN(10, phase_k(F)); SEAM(10);
    if (IN(11)) phase_l(F);
#undef IN
#undef SEAM
}

extern "C" void kernel_launch(void* const* d_in, const int* in_sizes, int n_in, void* d_out, int out_size, void* d_ws, size_t ws_size, hipStream_t stream) {
    static int grid = 0;
    if (grid == 0) {
        if (n_in != 22 || out_size != NLAT * D || ws_size < WS_END) { fprintf(stderr, "kernel_launch: unexpected shapes (n_in %d, out %d, ws %zu)\n", n_in, out_size, ws_size); grid = -1; return; }
        int dev = 0, cus = 0, per_cu = 0;
        hipGetDevice(&dev); hipDeviceGetAttribute(&cus, hipDeviceAttributeMultiprocessorCount, dev);
        if (hipFuncSetAttribute((const void*)mk_fwd, hipFuncAttributeMaxDynamicSharedMemorySize, LDS_BYTES) != hipSuccess) { fprintf(stderr, "kernel_launch: hipFuncSetAttribute failed\n"); grid = -1; return; }
        if (hipOccupancyMaxActiveBlocksPerMultiprocessor(&per_cu, (const void*)mk_fwd, 512, LDS_BYTES) != hipSuccess || per_cu < 1) fprintf(stderr, "kernel_launch: occupancy query says %d\n", per_cu);
        (void)hipGetLastError();
        grid = cus;
        if (grid != 256) fprintf(stderr, "kernel_launch: %d CUs (built for 256)\n", grid);
    }
    if (grid < 0) return;
    hipMemsetAsync((char*)d_ws + WS_CTL, 0, CTL_BYTES, stream);
    Params p{};
    for (int i = 0; i < 22; ++i) p.in[i] = (const float*)d_in[i];
    p.out = (float*)d_out; p.ws = (unsigned char*)d_ws;
#if MK_N_LAUNCHES == 1
    p.ph_lo = 0; p.ph_hi = NPH;
    void* args[] = {&p};
    hipError_t e = hipLaunchCooperativeKernel((const void*)mk_fwd, dim3(grid), dim3(512), args, LDS_BYTES, stream);
    if (e != hipSuccess) fprintf(stderr, "kernel_launch: cooperative launch failed: %s\n", hipGetErrorString(e));
#else
    for (int ph = 0; ph < NPH; ++ph) { p.ph_lo = ph; p.ph_hi = ph + 1; hipLaunchKernelGGL(mk_fwd, dim3(grid), dim3(512), LDS_BYTES, stream, p); }
#endif
}
```
